# Optimizing an MI355X kernel written in HIP

```python
import jax, jax.numpy as jnp
from jax import lax
import numpy as np

D_MODEL = 1024
BATCH = 8
SEQ = 2048
DEPTH = 4

HEAD_DIM = 64
DIL_PAIRS = ((128, 1), (512, 4), (2048, 16))
N_DIL_GROUPS = len(DIL_PAIRS)
DIL_HEADS_PER_GROUP = 4
DIL_HEADS = N_DIL_GROUPS * DIL_HEADS_PER_GROUP
SB_HEADS = 4
DIL_WIDTH = DIL_HEADS * HEAD_DIM
SB_WIDTH = SB_HEADS * HEAD_DIM
DIL_OUT_WIDTH = DIL_HEADS_PER_GROUP * HEAD_DIM
N_BRANCHES = 2
IN_COLS = 3 * DIL_WIDTH + 3 * SB_WIDTH + N_BRANCHES * D_MODEL
D_FF = 2816
CONV_WIDTH = 3
ROPE_THETA = 500000.0
ROPE_DIM = HEAD_DIM // 4
Q_BLOCK = 128
NORM_EPS = 1e-5
MAX_POS_OFFSET = 4096
MASK_VALUE = -1e30

kernel_name = "hybrid_dilated_stickbreaking_convffn"


def rms_norm(x, gain):
    xf = x.astype(jnp.float32)
    xf = xf * lax.rsqrt(jnp.mean(xf * xf, axis=-1, keepdims=True) + NORM_EPS)
    return (xf * gain.astype(jnp.float32)).astype(x.dtype)


def rope_tables(positions, dtype):
    inv_freq = ROPE_THETA ** (-jnp.arange(0, ROPE_DIM, 2, dtype=jnp.float32) / ROPE_DIM)
    ang = positions.astype(jnp.float32)[..., None] * inv_freq
    return (jnp.cos(ang)[:, :, None, None, :].astype(dtype),
            jnp.sin(ang)[:, :, None, None, :].astype(dtype))


def apply_partial_rope(x, cos, sin):
    half = ROPE_DIM // 2
    x1, x2, rest = x[..., :half], x[..., half:ROPE_DIM], x[..., ROPE_DIM:]
    return jnp.concatenate([x1 * cos - x2 * sin, x2 * cos + x1 * sin, rest], axis=-1)


def dilated_attention(q, k, v):
    b, s = q.shape[0], q.shape[1]
    n_blocks = s // Q_BLOCK
    scale = HEAD_DIM ** -0.5
    qs = [q[:, :, g] for g in range(N_DIL_GROUPS)]
    ks = [k[:, :, g] for g in range(N_DIL_GROUPS)]
    vs = [v[:, :, g] for g in range(N_DIL_GROUPS)]

    def block(t0):
        t = t0 + jnp.arange(Q_BLOCK)
        outs, lses = [], []
        for g, (window, dil) in enumerate(DIL_PAIRS):
            n_keys = window // dil + 1
            idx = t[:, None] - dil * jnp.arange(n_keys)[None, :]
            valid = idx >= 0
            idx = jnp.maximum(idx, 0)
            qg = lax.dynamic_slice_in_dim(qs[g], t0, Q_BLOCK, axis=1)
            kg = ks[g][:, idx]
            vg = vs[g][:, idx]
            sc = jnp.einsum('bqhd,bqkhd->bhqk', qg, kg).astype(jnp.float32) * scale
            sc = jnp.where(valid[None, None], sc, MASK_VALUE)
            m = jnp.max(sc, axis=-1, keepdims=True)
            p = jnp.exp(sc - m)
            den = jnp.sum(p, axis=-1)
            o = jnp.einsum('bhqk,bqkhd->bqhd', p, vg.astype(jnp.float32))
            o = o / jnp.transpose(den, (0, 2, 1))[..., None]
            outs.append(o)
            lses.append(m[..., 0] + jnp.log(den))
        o_all = jnp.stack(outs, axis=0)
        w = jax.nn.softmax(jnp.stack(lses, axis=0), axis=0)
        w = jnp.transpose(w, (0, 1, 3, 2))[..., None]
        return jnp.sum(w * o_all, axis=0).astype(q.dtype)

    out = lax.map(block, jnp.arange(n_blocks) * Q_BLOCK)
    return jnp.moveaxis(out, 0, 1).reshape(b, s, DIL_OUT_WIDTH)


def stick_breaking_attention(q, k, v):
    b, s = q.shape[0], q.shape[1]
    n_blocks = s // Q_BLOCK
    scale = HEAD_DIM ** -0.5
    key_pos = jnp.arange(s)

    def block(t0):
        qb = lax.dynamic_slice_in_dim(q, t0, Q_BLOCK, axis=1)
        z = jnp.einsum('bqhd,bkhd->bhqk', qb, k).astype(jnp.float32) * scale
        t = t0 + jnp.arange(Q_BLOCK)
        causal = key_pos[None, :] < t[:, None]
        log_keep = jnp.where(causal, jax.nn.log_sigmoid(-z), 0.0)
        suffix = lax.cumsum(log_keep, axis=3, reverse=True) - log_keep
        attn = jnp.where(causal, jnp.exp(jax.nn.log_sigmoid(z) + suffix), 0.0)
        return jnp.einsum('bhqk,bkhd->bqhd', attn, v.astype(jnp.float32)).astype(q.dtype)

    out = lax.map(block, jnp.arange(n_blocks) * Q_BLOCK)
    return jnp.moveaxis(out, 0, 1).reshape(b, s, SB_WIDTH)


def conv_ffn(h, w_up, conv_w, conv_b, w_down):
    up = h @ w_up
    a, bval = up[..., :D_FF], up[..., D_FF:]
    a = lax.conv_general_dilated(a, conv_w[:, None, :].astype(a.dtype), window_strides=(1,),
                                 padding=((CONV_WIDTH - 1, 0),),
                                 dimension_numbers=('NWC', 'WIO', 'NWC'),
                                 feature_group_count=D_FF) + conv_b
    return (jax.nn.silu(a) * bval) @ w_down


def setup_inputs(seed: int = 0) -> dict:
    key = jax.random.key(seed)
    ks = jax.random.split(key, 16)
    f32 = jnp.float32
    nrm = lambda k, shape, s: jax.random.normal(k, shape, f32) * s
    x = jax.random.normal(ks[0], (BATCH, SEQ, D_MODEL), f32)
    offset = jax.random.randint(ks[1], (BATCH, 1), 0, MAX_POS_OFFSET, dtype=jnp.int32)
    positions = offset + jnp.arange(SEQ, dtype=jnp.int32)[None, :]
    return {
        "x": x,
        "positions": positions,
        "norm_mix": 1.0 + nrm(ks[2], (DEPTH, D_MODEL), 0.05),
        "w_in": nrm(ks[3], (DEPTH, D_MODEL, IN_COLS), D_MODEL ** -0.5),
        "b_gate": nrm(ks[4], (DEPTH, N_BRANCHES * D_MODEL), 0.1),
        "w_proj_a": nrm(ks[5], (DEPTH, DIL_OUT_WIDTH, D_MODEL), DIL_OUT_WIDTH ** -0.5),
        "w_proj_b": nrm(ks[6], (DEPTH, SB_WIDTH, D_MODEL), SB_WIDTH ** -0.5),
        "w_out": nrm(ks[7], (DEPTH, D_MODEL, D_MODEL), D_MODEL ** -0.5),
        "norm_ffn": 1.0 + nrm(ks[8], (DEPTH, D_MODEL), 0.05),
        "w_up": nrm(ks[9], (DEPTH, D_MODEL, 2 * D_FF), D_MODEL ** -0.5),
        "conv_w": nrm(ks[10], (DEPTH, CONV_WIDTH, D_FF), CONV_WIDTH ** -0.5),
        "conv_b": nrm(ks[11], (DEPTH, D_FF), 0.02),
        "w_down": nrm(ks[12], (DEPTH, D_FF, D_MODEL), D_FF ** -0.5),
        "norm_final": 1.0 + nrm(ks[13], (D_MODEL,), 0.05),
    }


def reference(x, positions, norm_mix, w_in, b_gate, w_proj_a, w_proj_b, w_out,
              norm_ffn, w_up, conv_w, conv_b, w_down, norm_final):
    b, s, _ = x.shape
    cos, sin = rope_tables(positions, x.dtype)
    splits = np.cumsum([DIL_WIDTH, DIL_WIDTH, DIL_WIDTH, SB_WIDTH, SB_WIDTH, SB_WIDTH]).tolist()
    for l in range(DEPTH):
        h = rms_norm(x, norm_mix[l])
        proj = h @ w_in[l]
        dq, dk, dv, sq, sk, sv, gate_logits = jnp.split(proj, splits, axis=-1)
        dshape = (b, s, N_DIL_GROUPS, DIL_HEADS_PER_GROUP, HEAD_DIM)
        dq = apply_partial_rope(dq.reshape(dshape), cos, sin)
        dk = apply_partial_rope(dk.reshape(dshape), cos, sin)
        dv = dv.reshape(dshape)
        sshape = (b, s, SB_HEADS, HEAD_DIM)
        y_a = dilated_attention(dq, dk, dv) @ w_proj_a[l]
        y_b = stick_breaking_attention(sq.reshape(sshape), sk.reshape(sshape), sv.reshape(sshape)) @ w_proj_b[l]
        gates = jax.nn.sigmoid(gate_logits + b_gate[l])
        mixed = gates[..., :D_MODEL] * y_a + gates[..., D_MODEL:] * y_b
        x = x + mixed @ w_out[l]
        h = rms_norm(x, norm_ffn[l])
        x = x + conv_ffn(h, w_up[l], conv_w[l], conv_b[l], w_down[l])
    return rms_norm(x, norm_final)
```

```cpp
#include <hip/hip_runtime.h>
#include <hip/hip_cooperative_groups.h>
#include <cstdio>
#include <cstdint>
#include <cmath>
namespace cg = cooperative_groups;
namespace pg8 {
#define PG8_LAS __attribute__((address_space(3)))
typedef unsigned short bf16_t;
typedef short bf16x8 __attribute__((ext_vector_type(8)));
typedef float f32x4 __attribute__((ext_vector_type(4)));
typedef unsigned u32x4 __attribute__((ext_vector_type(4)));
constexpr int BM = 256, BK = 64, HALF = 128, HTB = HALF * BK * 2  , STAGE_BYTES = 8 * HTB, NXCD = 8, WGM = 8;

__host__ __device__ __forceinline__ int lds_byte(int r, int c) { const int st = (r >> 4) * 2 + (c >> 5), rr = r & 15, cc = c & 31, ob = rr * 64 + cc * 2; return st * 1024 + (ob ^ (((ob >> 9) & 1) << 5)); }
__host__ __device__ __forceinline__ void stage_rc(int b, int& R, int& C) { const int st = b / 1024, sb = b % 1024, swz = sb ^ (((sb >> 9) & 1) << 5); R = (st >> 1) * 16 + swz / 64; C = (st & 1) * 32 + (swz % 64) / 2; }
__host__ __device__ __forceinline__ int perm32(int rho) { const int n = rho >> 4, i = rho & 15; return 8 * (i >> 2) + 4 * n + (i & 3); }

struct Unit { int pm, pn; };
struct Gemm { const bf16_t* A; const bf16_t* Bt; int M, N, K; };

struct StaticOrder {
    int nM, nN, nwg, G, c;
    __host__ __device__ void init(int M, int N, int G_, int c_) { nM = M / BM; nN = N / BM; nwg = nM * nN; G = G_; c = c_; }
    __host__ __device__ bool next(int i, Unit& u) const {
        const long L = (long)i * G + c; if (L >= nwg) return false;
        int wgid = (int)L; { const int q = nwg / NXCD, r = nwg % NXCD, xcd = wgid % NXCD, off = wgid / NXCD; wgid = (xcd < r ? xcd * (q + 1) : r * (q + 1) + (xcd - r) * q) + off; }
        const int nig = WGM * nN, gid = wgid / nig, fm = gid * WGM, gsz = (nM - fm) < WGM ? (nM - fm) : WGM;
        u.pm = fm + ((wgid % nig) % gsz); u.pn = (wgid % nig) / gsz; return true;
    }
    __device__ __forceinline__ void a_ready(const Unit&) const {}
    __device__ __forceinline__ void done(const Unit&) const {}
};

__device__ __forceinline__ unsigned cvt_pk_bf16(float lo, float hi) { unsigned r; asm volatile("v_cvt_pk_bf16_f32 %0, %1, %2" : "=v"(r) : "v"(lo), "v"(hi)); return r; }
typedef float f32x2 __attribute__((ext_vector_type(2)));
__device__ __forceinline__ int lane_id_asm() { int l; asm volatile("v_mbcnt_lo_u32_b32 %0, -1, 0\n\tv_mbcnt_hi_u32_b32 %0, -1, %0" : "=v"(l)); return l; }
__device__ __forceinline__ float xor16f(float x) { return __int_as_float(__builtin_amdgcn_ds_swizzle(__float_as_int(x), 0x401F)); }
__device__ __forceinline__ float xor32f(float x) { const unsigned xi = __float_as_uint(x); auto rr = __builtin_amdgcn_permlane32_swap(xi, xi, false, false); return __uint_as_float(rr[0] == xi ? rr[1] : rr[0]); }
__device__ __forceinline__ float max32f(float x) { const unsigned xi = __float_as_uint(x); auto rr = __builtin_amdgcn_permlane32_swap(xi, xi, false, false); return fmaxf(__uint_as_float(rr[0]), __uint_as_float(rr[1])); }
__device__ __forceinline__ float bf_lo(unsigned w) { return __uint_as_float(w << 16); }
__device__ __forceinline__ float bf_hi(unsigned w) { return __uint_as_float(w & 0xffff0000u); }
__device__ __forceinline__ f32x4 ld_ss4(const float* ssp, int row, int fq) { return *(const f32x4*)(ssp + (size_t)row * 16 + 4 * fq); }
__device__ __forceinline__ float red_ss4(const f32x4 a) { float s = (a[0] + a[1]) + (a[2] + a[3]); s += xor16f(s); s += xor32f(s); return s; }
__device__ __forceinline__ u32x4 pack8(const f32x4 v0, const f32x4 v1) { u32x4 w; w.x = cvt_pk_bf16(v0[0], v0[1]); w.y = cvt_pk_bf16(v0[2], v0[3]); w.z = cvt_pk_bf16(v1[0], v1[1]); w.w = cvt_pk_bf16(v1[2], v1[3]); return w; }
__device__ __forceinline__ float sigmoidf_(float x) { return __builtin_amdgcn_rcpf(1.0f + __builtin_amdgcn_exp2f(x * -1.4426950408889634f)); }

struct EpiProj {
    static constexpr bool PERM = true, AFTER_DRAIN = false;
    bf16_t* O; const float* ss; const float* rope; const float* bgate; PG8_LAS float* rsc; mutable int cached_pm;
    __device__ __forceinline__ void operator()(const f32x4 (&acc)[2][2][4][2], const Unit& u, int wr, int wc, int fr_, int fq_) const {
        const int ln_ = lane_id_asm(), fr = ln_ & 15, fq = ln_ >> 4;
        const int row0 = u.pm * BM + wr * 64 + fr, col0 = u.pn * BM + wc * 32 + 8 * fq;
        const bool is_rope = (u.pn < 6) && ((wc & 1) == 0);
        const bool is_gate = (u.pn >= 12);
        float rs[8];
        const bool fresh = (u.pm != cached_pm);
        if (fresh) {
            f32x4 pr[8];
#pragma unroll
            for (int i = 0; i < 8; ++i) pr[i] = ld_ss4(ss, row0 + (i >> 2) * HALF + (i & 3) * 16, fq);
#pragma unroll
            for (int i = 0; i < 8; ++i) rs[i] = red_ss4(pr[i]);
        }
        f32x4 gb[2][2];
#pragma unroll
        for (int bj = 0; bj < 2; ++bj) { gb[bj][0] = (f32x4){0.f, 0.f, 0.f, 0.f}; gb[bj][1] = gb[bj][0];
            if (is_gate) { gb[bj][0] = *(const f32x4*)(bgate + col0 + bj * HALF - 3072); gb[bj][1] = *(const f32x4*)(bgate + col0 + bj * HALF - 3072 + 4); } }
        f32x4 gbn[2][2];
#pragma unroll
        for (int bj = 0; bj < 2; ++bj) { gbn[bj][0] = gb[bj][0] * -1.4426950408889634f; gbn[bj][1] = gb[bj][1] * -1.4426950408889634f; }
        if (fresh) {
#pragma unroll
            for (int i = 0; i < 8; ++i) { rs[i] = rsqrtf(rs[i] * (1.0f / 1024.0f) + 1e-5f); if (fq == 0) rsc[i * 16 + fr] = rs[i]; }
            cached_pm = u.pm;
        } else {
#pragma unroll
            for (int i = 0; i < 8; ++i) rs[i] = rsc[i * 16 + fr];
        }
#pragma unroll
        for (int ai2 = 0; ai2 < 4; ++ai2) {
            const int ai = ai2 >> 1;
            f32x4 rc[4][4];
            if (is_rope) {
#pragma unroll
                for (int m = (ai2 & 1) * 2; m < (ai2 & 1) * 2 + 2; ++m) { const float* rp = rope + (size_t)(row0 + ai * HALF + m * 16) * 16;
                    rc[m][0] = *(const f32x4*)rp; rc[m][1] = *(const f32x4*)(rp + 4); rc[m][2] = *(const f32x4*)(rp + 8); rc[m][3] = *(const f32x4*)(rp + 12); }
            }
#pragma unroll
            for (int m = (ai2 & 1) * 2; m < (ai2 & 1) * 2 + 2; ++m) {
                const int row = row0 + ai * HALF + m * 16;
                const float r = rs[ai * 4 + m];
#pragma unroll
                for (int bj = 0; bj < 2; ++bj) {
                    f32x4 v0, v1;
                    const int col = col0 + bj * HALF;
                    if (is_gate) {
                        const float rn = r * -1.4426950408889634f;
#pragma unroll
                        for (int i = 0; i < 4; ++i) { v0[i] = __builtin_amdgcn_rcpf(1.0f + __builtin_amdgcn_exp2f(fmaf(acc[ai][bj][m][0][i], rn, gbn[bj][0][i])));
                                                      v1[i] = __builtin_amdgcn_rcpf(1.0f + __builtin_amdgcn_exp2f(fmaf(acc[ai][bj][m][1][i], rn, gbn[bj][1][i]))); }
                    } else { v0 = acc[ai][bj][m][0] * r; v1 = acc[ai][bj][m][1] * r; }
                    if (is_rope) {
                        f32x4 o0, o1;
#pragma unroll
                        for (int i = 0; i < 4; ++i) { o0[i] = xor16f(v0[i]); o1[i] = xor16f(v1[i]); }
                        if (fq == 0) { v0 = v0 * rc[m][0] - o0 * rc[m][2]; v1 = v1 * rc[m][1] - o1 * rc[m][3]; }
                        else if (fq == 1) { v0 = v0 * rc[m][0] + o0 * rc[m][2]; v1 = v1 * rc[m][1] + o1 * rc[m][3]; }
                    }
                    *(u32x4*)(O + (size_t)row * 5120 + col) = pack8(v0, v1);
                }
            }
        }
    }
};
struct EpiUpConv {
    static constexpr bool PERM = true, AFTER_DRAIN = false;
    bf16_t* Gout; bf16_t* EXA; bf16_t* EXB; const float* ss; const float* cw; const float* cb; PG8_LAS float* rsc; mutable int cached_pm;
    __device__ __forceinline__ void operator()(const f32x4 (&acc)[2][2][4][2], const Unit& u, int wr, int wc, int fr_, int fq_) const {
        const int ln_ = lane_id_asm(), fr = ln_ & 15, fq = ln_ >> 4;
        const int ch0 = u.pn * 128 + wc * 32 + 8 * fq, row0 = u.pm * BM + wr * 64 + fr;
        float rs[8];
        const bool fresh = (u.pm != cached_pm);
        if (fresh) {
            f32x4 pr[8];
#pragma unroll
            for (int i = 0; i < 8; ++i) pr[i] = ld_ss4(ss, row0 + (i >> 2) * HALF + (i & 3) * 16, fq);
#pragma unroll
            for (int i = 0; i < 8; ++i) rs[i] = red_ss4(pr[i]);
        }
        f32x4 w0[2], w1[2], w2[2], wb[2];
#pragma unroll
        for (int n = 0; n < 2; ++n) { w0[n] = *(const f32x4*)(cw + ch0 + 4 * n); w1[n] = *(const f32x4*)(cw + 2816 + ch0 + 4 * n); w2[n] = *(const f32x4*)(cw + 5632 + ch0 + 4 * n); wb[n] = *(const f32x4*)(cb + ch0 + 4 * n); }
        if (fresh) {
#pragma unroll
            for (int i = 0; i < 8; ++i) { rs[i] = rsqrtf(rs[i] * (1.0f / 1024.0f) + 1e-5f); if (fq == 0) rsc[i * 16 + fr] = rs[i]; }
            cached_pm = u.pm;
        } else {
#pragma unroll
            for (int i = 0; i < 8; ++i) rs[i] = rsc[i * 16 + fr];
        }
        const int sl1 = ((ln_ & 48) | ((fr + 15) & 15)) << 2, sl2 = ((ln_ & 48) | ((fr + 14) & 15)) << 2;
#pragma unroll
        for (int ai = 0; ai < 2; ++ai) {
            const int chunk = 4 * u.pm + 2 * ai + wr;
            f32x4 s1p[2], s2p[2];
            s1p[0] = (f32x4){0.f, 0.f, 0.f, 0.f}; s1p[1] = s1p[0]; s2p[0] = s1p[0]; s2p[1] = s1p[0];
#pragma unroll
            for (int m = 0; m < 4; ++m) {
                const float r = rs[ai * 4 + m];
                f32x4 av[2], bv[2], g[2];
#pragma unroll
                for (int n = 0; n < 2; ++n) {
                    av[n] = acc[ai][0][m][n] * r; bv[n] = acc[ai][1][m][n] * r;
                    f32x4 s1, s2;
#pragma unroll
                    for (int e = 0; e < 4; ++e) { s1[e] = __int_as_float(__builtin_amdgcn_ds_bpermute(sl1, __float_as_int(av[n][e]))); s2[e] = __int_as_float(__builtin_amdgcn_ds_bpermute(sl2, __float_as_int(av[n][e]))); }
                    const f32x4 p1 = (fr == 0) ? s1p[n] : s1, p2 = (fr < 2) ? s2p[n] : s2;
                    s1p[n] = s1; s2p[n] = s2;
#pragma unroll
                    for (int e = 0; e < 4; ++e) { const float y = fmaf(w0[n][e], p2[e], fmaf(w1[n][e], p1[e], fmaf(w2[n][e], av[n][e], wb[n][e])));
                        g[n][e] = (y * sigmoidf_(y)) * bv[n][e]; }
                }
                const int row = row0 + ai * HALF + m * 16;
                if (m == 0 && fr < 2) {
                    *(u32x4*)(EXA + ((size_t)chunk * 4 + fr) * 2816 + ch0) = pack8(av[0], av[1]);
                    *(u32x4*)(EXB + ((size_t)chunk * 2 + fr) * 2816 + ch0) = pack8(bv[0], bv[1]);
                } else {
                    *(u32x4*)(Gout + (size_t)row * 2816 + ch0) = pack8(g[0], g[1]);
                    if (m == 3 && fr >= 14) *(u32x4*)(EXA + ((size_t)chunk * 4 + 2 + (fr - 14)) * 2816 + ch0) = pack8(av[0], av[1]);
                }
            }
        }
    }
};
template <int MODE> struct EpiGate {
    static constexpr bool PERM = true, AFTER_DRAIN = false;
    bf16_t* MIX; const bf16_t* PROJ;
    __device__ __forceinline__ void operator()(const f32x4 (&acc)[2][2][4][2], const Unit& u, int wr, int wc, int fr_, int fq_) const {
        const int ln_ = lane_id_asm(), fr = ln_ & 15, fq = ln_ >> 4;
        const int row0 = u.pm * BM + wr * 64 + fr, col0 = u.pn * BM + wc * 32 + 8 * fq;
#pragma unroll
        for (int ai = 0; ai < 2; ++ai) {
            u32x4 g[4][2], o[4][2];
#pragma unroll
            for (int m = 0; m < 4; ++m)
#pragma unroll
                for (int bj = 0; bj < 2; ++bj) { const int row = row0 + ai * HALF + m * 16, col = col0 + bj * HALF;
                    g[m][bj] = *(const u32x4*)(PROJ + (size_t)row * 5120 + (MODE == 0 ? 3072 : 4096) + col);
                    if (MODE == 1) o[m][bj] = *(const u32x4*)(MIX + (size_t)row * 1024 + col); }
#pragma unroll
            for (int m = 0; m < 4; ++m)
#pragma unroll
                for (int bj = 0; bj < 2; ++bj) { const int row = row0 + ai * HALF + m * 16, col = col0 + bj * HALF;
                    const f32x4 a0 = acc[ai][bj][m][0], a1 = acc[ai][bj][m][1]; const u32x4 gg = g[m][bj];
                    f32x4 v0 = {bf_lo(gg.x) * a0[0], bf_hi(gg.x) * a0[1], bf_lo(gg.y) * a0[2], bf_hi(gg.y) * a0[3]};
                    f32x4 v1 = {bf_lo(gg.z) * a1[0], bf_hi(gg.z) * a1[1], bf_lo(gg.w) * a1[2], bf_hi(gg.w) * a1[3]};
                    if (MODE == 1) { const u32x4 oo = o[m][bj];
                        v0 += (f32x4){bf_lo(oo.x), bf_hi(oo.x), bf_lo(oo.y), bf_hi(oo.y)}; v1 += (f32x4){bf_lo(oo.z), bf_hi(oo.z), bf_lo(oo.w), bf_hi(oo.w)}; }
                    *(u32x4*)(MIX + (size_t)row * 1024 + col) = pack8(v0, v1); }
        }
    }
};
struct EpiResid {
    static constexpr bool PERM = true, AFTER_DRAIN = false;
    const float* base; float* out; bf16_t* XB; float* ss;
    __device__ __forceinline__ void operator()(const f32x4 (&acc)[2][2][4][2], const Unit& u, int wr, int wc, int fr_, int fq_) const {
        const int ln_ = lane_id_asm(), fr = ln_ & 15, fq = ln_ >> 4;
        const int row0 = u.pm * BM + wr * 64 + fr, col0 = u.pn * BM + wc * 32 + 8 * fq;
#pragma unroll
        for (int ai2 = 0; ai2 < 4; ++ai2) {
            const int ai = ai2 >> 1;
            f32x4 b[4][2][2];
#pragma unroll
            for (int m = (ai2 & 1) * 2; m < (ai2 & 1) * 2 + 2; ++m)
#pragma unroll
                for (int bj = 0; bj < 2; ++bj) { const size_t off = (size_t)(row0 + ai * HALF + m * 16) * 1024 + col0 + bj * HALF; b[m][bj][0] = *(const f32x4*)(base + off); b[m][bj][1] = *(const f32x4*)(base + off + 4); }
#pragma unroll
            for (int m = (ai2 & 1) * 2; m < (ai2 & 1) * 2 + 2; ++m) {
                const int row = row0 + ai * HALF + m * 16; float part = 0.f;
#pragma unroll
                for (int bj = 0; bj < 2; ++bj) {
                    const size_t off = (size_t)row * 1024 + col0 + bj * HALF;
                    const f32x4 v0 = b[m][bj][0] + acc[ai][bj][m][0], v1 = b[m][bj][1] + acc[ai][bj][m][1];
                    *(f32x4*)(out + off) = v0; *(f32x4*)(out + off + 4) = v1;
                    *(u32x4*)(XB + off) = pack8(v0, v1);
                    part += (v0[0] * v0[0] + v0[1] * v0[1]) + (v0[2] * v0[2] + v0[3] * v0[3]) + (v1[0] * v1[0] + v1[1] * v1[1]) + (v1[2] * v1[2] + v1[3] * v1[3]);
                }
                part += xor16f(part); part += xor32f(part);
                if (fq == 0) ss[(size_t)row * 16 + u.pn * 4 + wc] = part;
            }
        }
    }
};
template <class Epi, class Sched, bool ALIGN_EPI = false, bool SP2 = false>
__device__ __forceinline__ void gemm_phase(PG8_LAS unsigned char* lds, const Gemm g, const Sched& S, const Epi& E, const int wave_s) {
    int wv_ = wave_s; asm volatile("" : "+s"(wv_)); const int lane_ = lane_id_asm(); const int tid = wv_ * 64 + lane_, wid = wv_, lane = tid & 63, wr = wid >> 2, wc = wid & 3, fr = lane & 15, fq = lane >> 4;
    const int K = g.K, nt = K / BK;
    unsigned voffA[2], voffB[2];
#pragma unroll
    for (int i = 0; i < 2; ++i) { int R, C; stage_rc(tid * 16 + i * 8192, R, C); const int Rb = Epi::PERM ? ((R & ~31) + perm32(R & 31)) : R;
        voffA[i] = (unsigned)(R * K + C) * 2u; voffB[i] = (unsigned)(Rb * K + C) * 2u; }
    const size_t kstep = (size_t)(BK * 2);
    const size_t hstep = (size_t)HALF * K * 2;
    const size_t tstep = 2 * hstep;
    const unsigned ldsw = (unsigned)wid * 1024u;
    const int aoff = lds_byte(wr * 64 + fr, fq * 8), boff = lds_byte(wc * 32 + fr, fq * 8);
#define PG8_SA(b, h) (((b) * 2 + (h)) * HTB)
#define PG8_SB(b, h) ((4 + (b) * 2 + (h)) * HTB)
#define PG8_STAGE(bufoff, gbase, voff) do { _Pragma("unroll") for (int _i = 0; _i < 2; ++_i) \
        __builtin_amdgcn_global_load_lds((const unsigned*)((const char*)(gbase) + (voff)[_i]), (PG8_LAS unsigned*)(lds + (bufoff) + ldsw + _i * 8192), 16, 0, 0); } while (0)
#define PG8_LDA(dst, b, h) do { _Pragma("unroll") for (int m = 0; m < 4; ++m) _Pragma("unroll") for (int k = 0; k < 2; ++k) dst[m][k] = *(const PG8_LAS bf16x8*)(lds + PG8_SA(b, h) + aoff + m * 2048 + k * 1024); } while (0)
#define PG8_LDB(dst, b, h) do { _Pragma("unroll") for (int n = 0; n < 2; ++n) _Pragma("unroll") for (int k = 0; k < 2; ++k) dst[n][k] = *(const PG8_LAS bf16x8*)(lds + PG8_SB(b, h) + boff + n * 2048 + k * 1024); } while (0)
#define PG8_MMA(ai, bj, At, Bt) do { __builtin_amdgcn_s_setprio(1); _Pragma("unroll") for (int m = 0; m < 4; ++m) _Pragma("unroll") for (int n = 0; n < 2; ++n) _Pragma("unroll") for (int k = 0; k < 2; ++k) \
        acc[ai][bj][m][n] = __builtin_amdgcn_mfma_f32_16x16x32_bf16(Bt[n][k], At[m][k], acc[ai][bj][m][n], 0, 0, 0); __builtin_amdgcn_s_setprio(0); } while (0)
#define PG8_WAIT_V(n) asm volatile("s_waitcnt vmcnt(" #n ")" ::: "memory")
#define PG8_WAIT_L(n) asm volatile("s_waitcnt lgkmcnt(" #n ")" ::: "memory")
#define PG8_BAR __builtin_amdgcn_s_barrier()
#define PG8_SCHED __builtin_amdgcn_sched_barrier(0)
    Unit cur, nxt; int ui = 0;
    if (!S.next(0, cur)) return;
    f32x4 acc[2][2][4][2];
#pragma unroll
    for (int a = 0; a < 2; ++a)
#pragma unroll
        for (int b = 0; b < 2; ++b)
#pragma unroll
            for (int m = 0; m < 4; ++m)
#pragma unroll
                for (int n = 0; n < 2; ++n) acc[a][b][m][n] = (f32x4){0.f, 0.f, 0.f, 0.f};
    bf16x8 At[4][2], B0[2][2], B1[2][2];
    const char* cA = (const char*)g.A + (size_t)cur.pm * tstep; const char* cB = (const char*)g.Bt + (size_t)cur.pn * tstep;
    S.a_ready(cur);
    if constexpr (SP2) {
        PG8_STAGE(PG8_SB(0, 0), cB, voffB); PG8_STAGE(PG8_SB(0, 1), cB + hstep, voffB); PG8_STAGE(PG8_SA(0, 0), cA, voffA); PG8_STAGE(PG8_SA(0, 1), cA + hstep, voffA);
        if (wr == 1) PG8_BAR;
        PG8_WAIT_V(2); PG8_BAR;
        PG8_STAGE(PG8_SB(1, 0), cB + kstep, voffB); PG8_STAGE(PG8_SA(1, 0), cA + kstep, voffA); PG8_STAGE(PG8_SB(1, 1), cB + hstep + kstep, voffB);
        PG8_WAIT_V(6); PG8_BAR;
    } else {
        PG8_STAGE(PG8_SB(0, 0), cB, voffB); PG8_STAGE(PG8_SA(0, 0), cA, voffA); PG8_STAGE(PG8_SB(0, 1), cB + hstep, voffB); PG8_STAGE(PG8_SA(0, 1), cA + hstep, voffA);
        if (wr == 1) PG8_BAR;
        PG8_WAIT_V(4); PG8_BAR;
        PG8_STAGE(PG8_SB(1, 0), cB + kstep, voffB); PG8_STAGE(PG8_SA(1, 0), cA + kstep, voffA); PG8_STAGE(PG8_SB(1, 1), cB + hstep + kstep, voffB);
        PG8_WAIT_V(6); PG8_BAR;
    }
    for (;;) {
        const bool has_next = S.next(ui + 1, nxt);
        const char* nA = has_next ? (const char*)g.A + (size_t)nxt.pm * tstep : cA; const char* nB = has_next ? (const char*)g.Bt + (size_t)nxt.pn * tstep : cB;
        for (int t = 0; t < nt; t += 2) {
            const bool last = (t == nt - 2);
            const char* a1 = cA + (size_t)(t + 1) * kstep;
            const char* a2 = last ? nA : cA + (size_t)(t + 2) * kstep; const char* b2 = last ? nB : cB + (size_t)(t + 2) * kstep;
            const char* a3 = a2 + kstep; const char* b3 = b2 + kstep;
            if (last && has_next) S.a_ready(nxt);
            if constexpr (SP2) {
            PG8_LDB(B0, 0, 0); PG8_LDB(B1, 0, 1); PG8_SCHED; PG8_LDA(At, 0, 0); PG8_STAGE(PG8_SA(1, 1), a1 + hstep, voffA);
            PG8_WAIT_V(8); PG8_WAIT_L(0); PG8_BAR; PG8_MMA(0, 0, At, B0); PG8_MMA(0, 1, At, B1); PG8_BAR; PG8_SCHED;
            PG8_LDA(At, 0, 1); PG8_STAGE(PG8_SB(0, 0), b2, voffB); PG8_STAGE(PG8_SB(0, 1), b2 + hstep, voffB); PG8_STAGE(PG8_SA(0, 0), a2, voffA);
            PG8_WAIT_V(8); PG8_WAIT_L(0); PG8_BAR; PG8_MMA(1, 0, At, B0); PG8_MMA(1, 1, At, B1); PG8_BAR; PG8_SCHED;
            PG8_LDB(B0, 1, 0); PG8_LDB(B1, 1, 1); PG8_SCHED; PG8_LDA(At, 1, 0); PG8_STAGE(PG8_SA(0, 1), a2 + hstep, voffA);
            PG8_WAIT_V(8); PG8_WAIT_L(0); PG8_BAR; PG8_MMA(0, 0, At, B0); PG8_MMA(0, 1, At, B1); PG8_BAR; PG8_SCHED;
            PG8_LDA(At, 1, 1); PG8_STAGE(PG8_SB(1, 0), b3, voffB); PG8_STAGE(PG8_SB(1, 1), b3 + hstep, voffB); PG8_STAGE(PG8_SA(1, 0), a3, voffA);
            PG8_WAIT_V(8); PG8_WAIT_L(0); PG8_BAR; PG8_MMA(1, 0, At, B0); PG8_MMA(1, 1, At, B1); PG8_BAR; PG8_SCHED;
            } else {
            PG8_LDB(B0, 0, 0); PG8_SCHED; PG8_LDA(At, 0, 0); PG8_STAGE(PG8_SA(1, 1), a1 + hstep, voffA);
            PG8_WAIT_L(8); PG8_BAR; PG8_WAIT_L(0); PG8_MMA(0, 0, At, B0); PG8_BAR; PG8_SCHED;
            PG8_LDB(B1, 0, 1); PG8_STAGE(PG8_SB(0, 0), b2, voffB);
            PG8_BAR; PG8_WAIT_L(0); PG8_MMA(0, 1, At, B1); PG8_BAR;
            PG8_LDA(At, 0, 1); PG8_STAGE(PG8_SA(0, 0), a2, voffA);
            PG8_BAR; PG8_WAIT_L(0); PG8_MMA(1, 0, At, B0); PG8_BAR; PG8_SCHED;
            PG8_STAGE(PG8_SB(0, 1), b2 + hstep, voffB);
            PG8_WAIT_V(6); PG8_BAR; PG8_MMA(1, 1, At, B1); PG8_BAR;
            PG8_LDB(B0, 1, 0); PG8_SCHED; PG8_LDA(At, 1, 0); PG8_STAGE(PG8_SA(0, 1), a2 + hstep, voffA);
            PG8_WAIT_L(8); PG8_BAR; PG8_WAIT_L(0); PG8_MMA(0, 0, At, B0); PG8_BAR; PG8_SCHED;
            PG8_LDB(B1, 1, 1); PG8_STAGE(PG8_SB(1, 0), b3, voffB);
            PG8_BAR; PG8_WAIT_L(0); PG8_MMA(0, 1, At, B1); PG8_BAR;
            PG8_LDA(At, 1, 1); PG8_STAGE(PG8_SA(1, 0), a3, voffA);
            PG8_BAR; PG8_WAIT_L(0); PG8_MMA(1, 0, At, B0); PG8_BAR; PG8_SCHED;
            PG8_STAGE(PG8_SB(1, 1), b3 + hstep, voffB);
            PG8_WAIT_V(6); PG8_BAR; PG8_MMA(1, 1, At, B1); PG8_BAR;
            }
        }
        if constexpr (ALIGN_EPI) { if (wr == 0) PG8_BAR; }
        if constexpr (!Epi::AFTER_DRAIN) { E(acc, cur, wr, wc, fr, fq); S.done(cur); }
        if (!has_next) break;
#pragma unroll
        for (int a = 0; a < 2; ++a)
#pragma unroll
            for (int b = 0; b < 2; ++b)
#pragma unroll
                for (int m = 0; m < 4; ++m)
#pragma unroll
                    for (int n = 0; n < 2; ++n) acc[a][b][m][n] = (f32x4){0.f, 0.f, 0.f, 0.f};
        cur = nxt; cA = nA; cB = nB; ++ui;
        if constexpr (ALIGN_EPI) { if (wr == 1) PG8_BAR; }
    }
    PG8_WAIT_V(0);
    if constexpr (!ALIGN_EPI) { if (wr == 0) PG8_BAR; }
    PG8_BAR;
    if constexpr (Epi::AFTER_DRAIN) { E.fused(acc, cur, wr, wc, fr, fq, lds, wid, lane); S.done(cur); }
#undef PG8_SA
#undef PG8_SB
#undef PG8_STAGE
#undef PG8_LDA
#undef PG8_LDB
#undef PG8_MMA
#undef PG8_WAIT_V
#undef PG8_WAIT_L
#undef PG8_BAR
#undef PG8_SCHED
}
}

#define LAS __attribute__((address_space(3)))
#define GAS __attribute__((address_space(1)))
typedef unsigned short bf16_t;
typedef short bf16x8 __attribute__((ext_vector_type(8)));
typedef short s16x4 __attribute__((ext_vector_type(4)));
typedef float f32x4 __attribute__((ext_vector_type(4)));
typedef unsigned u32x4 __attribute__((ext_vector_type(4)));
typedef unsigned u32x2 __attribute__((ext_vector_type(2)));
constexpr int M = 16384, D = 1024, SEQ = 2048, DEPTH = 4, NIN = 5120, DFF = 2816, NUP = 5632;
constexpr size_t MiB = 1u << 20;
constexpr size_t WS_SS = 302 * MiB;
constexpr size_t WS_ROPE = 1 * MiB;
constexpr size_t WS_W = 2 * MiB, W_SET = 30 * MiB;
constexpr size_t W_IN = 0, W_PA = 10 * MiB, W_PB = W_PA + MiB / 2, W_OUT = 11 * MiB, W_UP = 13 * MiB, W_DN = 24 * MiB;
constexpr size_t WS_XB = 62 * MiB;
constexpr size_t WS_PROJ = 94 * MiB;
constexpr size_t WS_ATTA = 254 * MiB, WS_ATTB = 262 * MiB;
constexpr size_t WS_MIX = 270 * MiB;
constexpr size_t WS_G = 94 * MiB;
constexpr size_t WS_EXA = 182 * MiB, WS_EXB = 190 * MiB;
constexpr size_t WS_END = 311 * MiB;
constexpr int LDS_BYTES = 147456;
constexpr int NWAVES = 8;

struct Args { const float* x; const int* pos; const float* norm_mix; const float* w_in; const float* b_gate; const float* w_proj_a; const float* w_proj_b; const float* w_out;
              const float* norm_ffn; const float* w_up; const float* conv_w; const float* conv_b; const float* w_down; const float* norm_final; float* out; unsigned char* ws; float inv_freq[8]; };

__device__ __forceinline__ float wave_sum(float v) {
#pragma unroll
    for (int o = 1; o < 64; o <<= 1) v += __shfl_xor(v, o);
    return v;
}
__device__ __forceinline__ unsigned pk2(float lo, float hi) { return pg8::cvt_pk_bf16(lo, hi); }
__device__ __forceinline__ float bflo(unsigned w) { return __uint_as_float(w << 16); }
__device__ __forceinline__ float bfhi(unsigned w) { return __uint_as_float(w & 0xffff0000u); }

__device__ __forceinline__ void transpose_item(const float* W, int K, int N, const float* gain, bf16_t* WT, int item, int lane, bool perm_up = false) {
    const int nblk = N / 64, kb = item / nblk, nb = item % nblk, k0 = 64 * kb, n0 = 64 * nb;
    int n0d = n0;
    if (perm_up) { const int c = n0 < DFF ? n0 : n0 - DFF; n0d = (c >> 7) * 256 + (c & 127) + (n0 < DFF ? 0 : 128); }
    const float* src = W + (size_t)k0 * N + n0 + lane;
    float v[64];
#pragma unroll
    for (int kk = 0; kk < 64; ++kk) v[kk] = src[(size_t)kk * N];
    if (gain) {
#pragma unroll
        for (int k4 = 0; k4 < 16; ++k4) { const f32x4 gq = *(const f32x4*)(gain + k0 + 4 * k4);
#pragma unroll
            for (int e = 0; e < 4; ++e) v[4 * k4 + e] *= gq[e]; }
    }
    bf16_t* dst = WT + (size_t)(n0d + lane) * K + k0;
#pragma unroll
    for (int c = 0; c < 8; ++c) { u32x4 o; o.x = pk2(v[8 * c], v[8 * c + 1]); o.y = pk2(v[8 * c + 2], v[8 * c + 3]); o.z = pk2(v[8 * c + 4], v[8 * c + 5]); o.w = pk2(v[8 * c + 6], v[8 * c + 7]);
        *(u32x4*)(dst + 8 * c) = o; }
}
__device__ __forceinline__ void convert_layer(const Args& a, int l, LAS unsigned char* lds, int gw, int ngw, int wave, int lane) {
    unsigned char* set = a.ws + WS_W + (size_t)(l & 1) * W_SET;
    constexpr int I_IN = (D / 64) * (NIN / 64), I_P = (256 / 64) * (D / 64), I_O = (D / 64) * (D / 64), I_UP = (D / 64) * (NUP / 64), I_DN = (DFF / 64) * (D / 64);
    constexpr int NITEMS = I_IN + 2 * I_P + I_O + I_UP + I_DN;
    for (int it = gw; it < NITEMS; it += ngw) {
        int r = it;
        if (r < I_IN) { transpose_item(a.w_in + (size_t)l * D * NIN, D, NIN, a.norm_mix + l * D, (bf16_t*)(set + W_IN), r, lane); continue; } r -= I_IN;
        if (r < I_P) { transpose_item(a.w_proj_a + (size_t)l * 256 * D, 256, D, nullptr, (bf16_t*)(set + W_PA), r, lane); continue; } r -= I_P;
        if (r < I_P) { transpose_item(a.w_proj_b + (size_t)l * 256 * D, 256, D, nullptr, (bf16_t*)(set + W_PB), r, lane); continue; } r -= I_P;
        if (r < I_O) { transpose_item(a.w_out + (size_t)l * D * D, D, D, nullptr, (bf16_t*)(set + W_OUT), r, lane); continue; } r -= I_O;
        if (r < I_UP) { transpose_item(a.w_up + (size_t)l * D * NUP, D, NUP, a.norm_ffn + l * D, (bf16_t*)(set + W_UP), r, lane, true); continue; } r -= I_UP;
        transpose_item(a.w_down + (size_t)l * DFF * D, DFF, D, nullptr, (bf16_t*)(set + W_DN), r, lane);
    }
}

constexpr int VROW = 144;
constexpr float LOG2E = 1.4426950408889634f;
struct TileRegs { bf16x8 k0, k1; u32x4 v0, v1; };
__device__ __forceinline__ void load_tile(TileRegs& t, const bf16_t* kp, const bf16_t* vp) {
    t.k0 = *(const bf16x8*)kp; t.k1 = *(const bf16x8*)(kp + 32); t.v0 = *(const u32x4*)vp; t.v1 = *(const u32x4*)(vp + 8);
}
typedef short v4i16_t __attribute__((ext_vector_type(4)));
__device__ __forceinline__ s16x4 vtr(const LAS unsigned char* p) { return __builtin_bit_cast(s16x4, __builtin_amdgcn_ds_read_tr16_b64_v4i16((LAS v4i16_t*)p)); }
__device__ __forceinline__ void pv_tile(f32x4 (&O)[4], LAS unsigned char* vlds, const u32x4 vr0, const u32x4 vr1, const s16x4 pf, int lane) {
    LAS unsigned char* wp = vlds + (lane >> 2) * VROW + (lane & 3) * 32;
    *(LAS u32x4*)wp = vr0; *(LAS u32x4*)(wp + 16) = vr1;
    asm volatile("" ::: "memory");
    const int fr = lane & 15, fq = lane >> 4;
    const LAS unsigned char* rp = vlds + (4 * fq + (fr >> 2)) * VROW + (fr & 3) * 8;
#pragma unroll
    for (int dt = 0; dt < 4; ++dt) { const s16x4 vt = vtr(rp + dt * 32); O[dt] = __builtin_amdgcn_mfma_f32_16x16x16bf16_1k(vt, pf, O[dt], 0, 0, 0); }
    asm volatile("" ::: "memory");
}
__device__ __forceinline__ s16x4 pack_p(const float (&p)[4]) { u32x2 w; w.x = pk2(p[0], p[1]); w.y = pk2(p[2], p[3]); return __builtin_bit_cast(s16x4, w); }
__device__ __forceinline__ int clampi(int v, int lo, int hi) { return v < lo ? lo : (v > hi ? hi : v); }

constexpr int NH = 2;
constexpr int NQ = 2;
constexpr int RSTEP = 16 / NQ, RSH = (NQ == 4 ? 2 : 3);
struct DilGeo { const bf16_t* kcol; const bf16_t* vcol; int rg, dl, ulo, NT; };
__device__ __forceinline__ void dil_load(TileRegs& dst, const DilGeo& G_, int kt, int lane) {
    const int fr = lane & 15;
    const int tk = clampi(G_.rg + G_.dl * (G_.ulo + 16 * kt + fr), 0, SEQ - 1), tv = clampi(G_.rg + G_.dl * (G_.ulo + 16 * kt + (lane >> 2)), 0, SEQ - 1);
    load_tile(dst, G_.kcol + (size_t)tk * NIN, G_.vcol + (size_t)tv * NIN);
}
__device__ __forceinline__ f32x4 qk_mfma(const bf16x8 k0, const bf16x8 q0, const bf16x8 k1, const bf16x8 q1) {
    f32x4 s;
    asm volatile("s_nop 1\n\tv_mfma_f32_16x16x32_bf16 %0, %1, %2, 0\n\tv_mfma_f32_16x16x32_bf16 %0, %3, %4, %0\n\ts_nop 7\n\ts_nop 7" : "=&v"(s) : "v"(k0), "v"(q0), "v"(k1), "v"(q1));
    return s;
}
__device__ __forceinline__ void pv_mfma(f32x4 (&O)[4], const s16x4 (&vt)[4], const s16x4 pf) {
    asm volatile("s_nop 1\n\tv_mfma_f32_16x16x16_bf16 %0, %4, %8, %0\n\tv_mfma_f32_16x16x16_bf16 %1, %5, %8, %1\n\tv_mfma_f32_16x16x16_bf16 %2, %6, %8, %2\n\tv_mfma_f32_16x16x16_bf16 %3, %7, %8, %3\n\ts_nop 7\n\ts_nop 7"
                 : "+v"(O[0]), "+v"(O[1]), "+v"(O[2]), "+v"(O[3]) : "v"(vt[0]), "v"(vt[1]), "v"(vt[2]), "v"(vt[3]), "v"(pf));
}
__device__ __forceinline__ void stage_v(s16x4 (&vt)[4], LAS unsigned char* vlds, const u32x4 vr0, const u32x4 vr1, int lane) {
    LAS unsigned char* wp = vlds + (lane >> 2) * VROW + (lane & 3) * 32;
    *(LAS u32x4*)wp = vr0; *(LAS u32x4*)(wp + 16) = vr1;
    asm volatile("" ::: "memory");
    const int fr = lane & 15, fq = lane >> 4;
    const LAS unsigned char* rp = vlds + (4 * fq + (fr >> 2)) * VROW + (fr & 3) * 8;
#pragma unroll
    for (int dt = 0; dt < 4; ++dt) vt[dt] = vtr(rp + dt * 32);
    asm volatile("" ::: "memory");
}
__device__ __forceinline__ void dil_pair(const TileRegs& cur, const s16x4 (&vt)[4], const bf16x8 q0, const bf16x8 q1, int ub, int uq, float& m_run, float& l_run, f32x4 (&O)[4]) {
    const f32x4 s = qk_mfma(cur.k0, q0, cur.k1, q1);
    const int d0 = ub - uq + 128;
    float sm[4];
#pragma unroll
    for (int v = 0; v < 4; ++v) { const bool ok = ((unsigned)(d0 + v) <= 128u) & ((ub + v) >= 0); sm[v] = ok ? s[v] : -INFINITY; }
    float tr = fmaxf(fmaxf(sm[0], sm[1]), fmaxf(sm[2], sm[3]));
    tr = fmaxf(tr, pg8::xor16f(tr)); tr = pg8::max32f(tr);
    const float tmax = tr * (0.125f * LOG2E);
    if (__builtin_amdgcn_ballot_w64(tmax > m_run + 8.0f) != 0ull) {
        asm volatile("" ::: );
        const float m_new = (tmax > m_run + 8.0f) ? tmax : m_run;
        const float alpha = __builtin_amdgcn_exp2f(m_run - m_new);
        m_run = m_new; l_run *= alpha;
#pragma unroll
        for (int dt = 0; dt < 4; ++dt) O[dt] = O[dt] * alpha;
    }
    float p[4];
#pragma unroll
    for (int v = 0; v < 4; ++v) p[v] = __builtin_amdgcn_exp2f(fmaf(sm[v], 0.125f * LOG2E, -m_run));
    l_run += (p[0] + p[1]) + (p[2] + p[3]);
    pv_mfma(O, vt, pack_p(p));
}
__device__ __forceinline__ void dil_tile_shared(const TileRegs& cur, const DilGeo& G_, int kt, const bf16x8 (&q0)[NQ], const bf16x8 (&q1)[NQ], const int (&uq)[NQ],
                                                float (&m_run)[NQ], float (&l_run)[NQ], f32x4 (&O)[NQ][4], LAS unsigned char* vlds, int lane) {
    s16x4 vt[4]; stage_v(vt, vlds, cur.v0, cur.v1, lane);
    const int ub = G_.ulo + 16 * kt + 4 * (lane >> 4);
#pragma unroll
    for (int c = 0; c < NQ; ++c) { dil_pair(cur, vt, q0[c], q1[c], ub, uq[c], m_run[c], l_run[c], O[c]); if (c & 1) __builtin_amdgcn_sched_barrier(0); }
}
__device__ __forceinline__ void dil_tile_one(const TileRegs& cur, const DilGeo& G_, int kt, const bf16x8 q0, const bf16x8 q1, int uq, float& m_run, float& l_run, f32x4 (&O)[4], LAS unsigned char* vlds, int lane) {
    s16x4 vt[4]; stage_v(vt, vlds, cur.v0, cur.v1, lane);
    dil_pair(cur, vt, q0, q1, G_.ulo + 16 * kt + 4 * (lane >> 4), uq, m_run, l_run, O);
}
__device__ __forceinline__ void dil_unit(const bf16_t* PROJ, bf16_t* ATTA, LAS unsigned char* vlds, int unit, int lane) {
    const int fr = lane & 15, fq = lane >> 4;
    const int iblk = unit & 7, r4 = (unit >> 3) & (RSTEP - 1), h = (unit >> (3 + RSH)) & 3, b = unit >> (5 + RSH);
    const bf16_t* base = PROJ + (size_t)b * SEQ * NIN;
    const int i0 = iblk * 16;
    float m_run[NQ], l_run[NQ];
    f32x4 O[NQ][4];
    float z0_ = 0.f; asm volatile("" : "+v"(z0_));
#pragma unroll
    for (int c = 0; c < NQ; ++c) { m_run[c] = -1e30f + z0_; l_run[c] = z0_;
#pragma unroll
        for (int dt = 0; dt < 4; ++dt) O[c][dt] = (f32x4){z0_, z0_, z0_, z0_}; }
#pragma unroll 1
    for (int g = 0; g < 2; ++g) {
        const int sh = 2 * g, dl = 1 << sh, sq = 16 >> sh;
        const int rg = r4 & (dl - 1);
        const int colq = g * 256 + h * 64;
        bf16x8 q0[NQ], q1[NQ]; int uq[NQ];
#pragma unroll
        for (int c = 0; c < NQ; ++c) { const int rc = r4 + RSTEP * c, tq = rc + 16 * (i0 + fr);
            const bf16_t* qp = base + (size_t)tq * NIN + colq + 8 * fq; q0[c] = *(const bf16x8*)qp; q1[c] = *(const bf16x8*)(qp + 32);
            uq[c] = ((rc - rg) >> sh) + sq * i0 + sq * fr; }
        DilGeo G_; G_.kcol = base + 768 + colq + 8 * fq; G_.vcol = base + 1536 + colq + 16 * (lane & 3); G_.rg = rg; G_.dl = dl;
        G_.ulo = ((r4 - rg) >> sh) + sq * i0 - 128;
        G_.NT = (g == 0) ? 24 : 12;
        const int NT = G_.NT;
        int kt = G_.ulo >= 0 ? 0 : ((-G_.ulo) >> 4);
        TileRegs b0, b1, b2;
        dil_load(b0, G_, kt, lane);
        dil_load(b1, G_, kt + 1 < NT ? kt + 1 : NT - 1, lane);
#pragma unroll 1
        for (; kt < NT; kt += 3) {
            dil_load(b2, G_, kt + 2 < NT ? kt + 2 : NT - 1, lane);
            dil_tile_shared(b0, G_, kt, q0, q1, uq, m_run, l_run, O, vlds, lane);
            dil_load(b0, G_, kt + 3 < NT ? kt + 3 : NT - 1, lane);
            dil_tile_shared(b1, G_, kt + 1, q0, q1, uq, m_run, l_run, O, vlds, lane);
            dil_load(b1, G_, kt + 4 < NT ? kt + 4 : NT - 1, lane);
            dil_tile_shared(b2, G_, kt + 2, q0, q1, uq, m_run, l_run, O, vlds, lane);
        }
    }
#pragma unroll
    for (int c = 0; c < NQ; ++c) {
        const int rc = r4 + RSTEP * c, tq = rc + 16 * (i0 + fr);
        const int colq = 2 * 256 + h * 64;
        const bf16_t* qp = base + (size_t)tq * NIN + colq + 8 * fq;
        const bf16x8 q0 = *(const bf16x8*)qp, q1 = *(const bf16x8*)(qp + 32);
        const int uq = i0 + fr;
        DilGeo G_; G_.kcol = base + 768 + colq + 8 * fq; G_.vcol = base + 1536 + colq + 16 * (lane & 3); G_.rg = rc; G_.dl = 16; G_.ulo = i0 - 128; G_.NT = 9;
        int kt = G_.ulo >= 0 ? 0 : ((-G_.ulo) >> 4);
        TileRegs b0, b1, b2;
        dil_load(b0, G_, kt, lane);
        dil_load(b1, G_, kt + 1 < 9 ? kt + 1 : 8, lane);
#pragma unroll 1
        for (; kt < 9; kt += 3) {
            dil_load(b2, G_, kt + 2 < 9 ? kt + 2 : 8, lane);
            dil_tile_one(b0, G_, kt, q0, q1, uq, m_run[c], l_run[c], O[c], vlds, lane);
            dil_load(b0, G_, kt + 3 < 9 ? kt + 3 : 8, lane);
            dil_tile_one(b1, G_, kt + 1, q0, q1, uq, m_run[c], l_run[c], O[c], vlds, lane);
            dil_load(b1, G_, kt + 4 < 9 ? kt + 4 : 8, lane);
            dil_tile_one(b2, G_, kt + 2, q0, q1, uq, m_run[c], l_run[c], O[c], vlds, lane);
        }
    }
#pragma unroll
    for (int c = 0; c < NQ; ++c) {
        const int tq = r4 + RSTEP * c + 16 * (i0 + fr);
        float l = l_run[c]; l += pg8::xor16f(l); l += pg8::xor32f(l);
        const float inv = 1.0f / l;
        bf16_t* op = ATTA + (size_t)(b * SEQ + tq) * 256 + h * 64 + 4 * fq;
#pragma unroll
        for (int dt = 0; dt < 4; ++dt) { u32x2 w; w.x = pk2(O[c][dt][0] * inv, O[c][dt][1] * inv); w.y = pk2(O[c][dt][2] * inv, O[c][dt][3] * inv); *(u32x2*)(op + 16 * dt) = w; }
    }
}

__device__ __forceinline__ void unpack8(const u32x4 w, float (&f)[8]);
constexpr int NAT_O = 0, NAT_LSE = 98304, NAT_V = 102400;
__device__ __forceinline__ void nat_store(LAS unsigned char* lds, int g, int tl, f32x4 (&O)[4], float m_run, float l_run, int lane) {
    const int fq = lane >> 4;

    float l = l_run; l += pg8::xor16f(l); l += pg8::xor32f(l);
    const float inv = 1.0f / l;
    LAS unsigned char* op = lds + NAT_O + (g * 256 + tl) * 128 + 8 * fq;
#pragma unroll
    for (int dt = 0; dt < 4; ++dt) { u32x2 w; w.x = pk2(O[dt][0] * inv, O[dt][1] * inv); w.y = pk2(O[dt][2] * inv, O[dt][3] * inv); *(LAS u32x2*)(op + 32 * dt) = w; }
    if (fq == 0) *(LAS float*)(lds + NAT_LSE + (g * 256 + tl) * 4) = m_run + __log2f(l);
}
__device__ __forceinline__ void nat_two(const bf16_t* base, int h, int g, int rg, int dl, int u0, int ublk0, LAS unsigned char* lds, LAS unsigned char* vlds, int lane) {
    const int fr = lane & 15, fq = lane >> 4;
    const int colq = g * 256 + h * 64;
    float z0_ = 0.f; asm volatile("" : "+v"(z0_));
    float m_run[2], l_run[2]; f32x4 O[2][4]; bf16x8 q0[2], q1[2]; int uq[2];
#pragma unroll
    for (int c = 0; c < 2; ++c) { m_run[c] = -1e30f + z0_; l_run[c] = z0_; uq[c] = u0 + 16 * c + fr;
        const bf16_t* qp = base + (size_t)(rg + dl * uq[c]) * NIN + colq + 8 * fq; q0[c] = *(const bf16x8*)qp; q1[c] = *(const bf16x8*)(qp + 32);
#pragma unroll
        for (int dt = 0; dt < 4; ++dt) O[c][dt] = (f32x4){z0_, z0_, z0_, z0_}; }
    DilGeo G_; G_.kcol = base + 768 + colq + 8 * fq; G_.vcol = base + 1536 + colq + 16 * (lane & 3); G_.rg = rg; G_.dl = dl; G_.ulo = u0 - 128; G_.NT = 10;
    int kt = G_.ulo >= 0 ? 0 : ((-G_.ulo) >> 4);
    TileRegs b0, b1, b2;
    dil_load(b0, G_, kt, lane);
    dil_load(b1, G_, kt + 1 < 10 ? kt + 1 : 9, lane);
#define NAT_STEP(buf, t) do { if ((t) < 10) { s16x4 vt_[4]; stage_v(vt_, vlds, buf.v0, buf.v1, lane); const int ub_ = G_.ulo + 16 * (t) + 4 * fq; \
        if ((t) <= 8) dil_pair(buf, vt_, q0[0], q1[0], ub_, uq[0], m_run[0], l_run[0], O[0]); \
        if ((t) >= 1) dil_pair(buf, vt_, q0[1], q1[1], ub_, uq[1], m_run[1], l_run[1], O[1]); } } while (0)
#pragma unroll 1
    for (; kt < 10; kt += 3) {
        dil_load(b2, G_, kt + 2 < 10 ? kt + 2 : 9, lane);
        NAT_STEP(b0, kt);
        dil_load(b0, G_, kt + 3 < 10 ? kt + 3 : 9, lane);
        NAT_STEP(b1, kt + 1);
        dil_load(b1, G_, kt + 4 < 10 ? kt + 4 : 9, lane);
        NAT_STEP(b2, kt + 2);
    }
#undef NAT_STEP
#pragma unroll
    for (int c = 0; c < 2; ++c) nat_store(lds, g, rg + dl * (u0 + 16 * c + fr - ublk0), O[c], m_run[c], l_run[c], lane);
}
__device__ __forceinline__ void nat_one(const bf16_t* base, int h, int g, int rg, int dl, int u0, int ublk0, LAS unsigned char* lds, LAS unsigned char* vlds, int lane) {
    const int fr = lane & 15, fq = lane >> 4;
    const int colq = g * 256 + h * 64;
    float z0_ = 0.f; asm volatile("" : "+v"(z0_));
    float m_run = -1e30f + z0_, l_run = z0_; f32x4 O[4];
#pragma unroll
    for (int dt = 0; dt < 4; ++dt) O[dt] = (f32x4){z0_, z0_, z0_, z0_};
    const int uq = u0 + fr;
    const bf16_t* qp = base + (size_t)(rg + dl * uq) * NIN + colq + 8 * fq;
    const bf16x8 q0 = *(const bf16x8*)qp, q1 = *(const bf16x8*)(qp + 32);
    DilGeo G_; G_.kcol = base + 768 + colq + 8 * fq; G_.vcol = base + 1536 + colq + 16 * (lane & 3); G_.rg = rg; G_.dl = dl; G_.ulo = u0 - 128; G_.NT = 9;
    int kt = G_.ulo >= 0 ? 0 : ((-G_.ulo) >> 4);
    TileRegs b0, b1, b2;
    dil_load(b0, G_, kt, lane);
    dil_load(b1, G_, kt + 1 < 9 ? kt + 1 : 8, lane);
#pragma unroll 1
    for (; kt < 9; kt += 3) {
        dil_load(b2, G_, kt + 2 < 9 ? kt + 2 : 8, lane);
        dil_tile_one(b0, G_, kt, q0, q1, uq, m_run, l_run, O, vlds, lane);
        dil_load(b0, G_, kt + 3 < 9 ? kt + 3 : 8, lane);
        dil_tile_one(b1, G_, kt + 1, q0, q1, uq, m_run, l_run, O, vlds, lane);
        dil_load(b1, G_, kt + 4 < 9 ? kt + 4 : 8, lane);
        dil_tile_one(b2, G_, kt + 2, q0, q1, uq, m_run, l_run, O, vlds, lane);
    }
    nat_store(lds, g, rg + dl * (uq - ublk0), O, m_run, l_run, lane);
}
__device__ __forceinline__ void dil_block(const bf16_t* PROJ, bf16_t* ATTA, LAS unsigned char* lds, int unit, int wave, int lane) {
    const int blk = unit & 7, h = (unit >> 3) & 3, b = unit >> 5;
    const bf16_t* base = PROJ + (size_t)b * SEQ * NIN;
    LAS unsigned char* vlds = lds + NAT_V + wave * 2304;
    const int t0 = 256 * blk;
    nat_two(base, h, 0, 0, 1, t0 + 32 * wave, t0, lds, vlds, lane);
    nat_two(base, h, 1, wave >> 1, 4, (t0 >> 2) + 32 * (wave & 1), t0 >> 2, lds, vlds, lane);
    nat_one(base, h, 2, 2 * wave, 16, t0 >> 4, t0 >> 4, lds, vlds, lane);
    nat_one(base, h, 2, 2 * wave + 1, 16, t0 >> 4, t0 >> 4, lds, vlds, lane);
    asm volatile("s_waitcnt lgkmcnt(0)" ::: "memory"); __syncthreads();
    for (int it = wave * 64 + lane; it < 256 * 8; it += NWAVES * 64) {
        const int tl = it >> 3, c8 = it & 7;
        const float e0 = *(const LAS float*)(lds + NAT_LSE + (0 * 256 + tl) * 4), e1 = *(const LAS float*)(lds + NAT_LSE + (1 * 256 + tl) * 4), e2 = *(const LAS float*)(lds + NAT_LSE + (2 * 256 + tl) * 4);
        const float mx = fmaxf(e0, fmaxf(e1, e2));
        float w0 = __builtin_amdgcn_exp2f(e0 - mx), w1 = __builtin_amdgcn_exp2f(e1 - mx), w2 = __builtin_amdgcn_exp2f(e2 - mx);
        const float inv = 1.0f / (w0 + w1 + w2); w0 *= inv; w1 *= inv; w2 *= inv;
        const u32x4 a = *(const LAS u32x4*)(lds + NAT_O + (0 * 256 + tl) * 128 + 16 * c8), bq = *(const LAS u32x4*)(lds + NAT_O + (1 * 256 + tl) * 128 + 16 * c8),
                    cq = *(const LAS u32x4*)(lds + NAT_O + (2 * 256 + tl) * 128 + 16 * c8);
        float fa[8], fb[8], fc[8], o[8];
        unpack8(a, fa); unpack8(bq, fb); unpack8(cq, fc);
#pragma unroll
        for (int e = 0; e < 8; ++e) o[e] = w0 * fa[e] + w1 * fb[e] + w2 * fc[e];
        u32x4 w; w.x = pk2(o[0], o[1]); w.y = pk2(o[2], o[3]); w.z = pk2(o[4], o[5]); w.w = pk2(o[6], o[7]);
        *(u32x4*)(ATTA + (size_t)(b * SEQ + t0 + tl) * 256 + h * 64 + 8 * c8) = w;
    }
    asm volatile("s_waitcnt lgkmcnt(0)" ::: "memory"); __syncthreads();
}

__device__ __forceinline__ void sb_load(TileRegs (&dst)[NH], const bf16_t* kcol, const bf16_t* vcol, int kt) {
#pragma unroll
    for (int hh = 0; hh < NH; ++hh) load_tile(dst[hh], kcol + (size_t)(16 * kt) * NIN + 64 * hh, vcol + (size_t)(16 * kt) * NIN + 64 * hh);
}
__device__ __forceinline__ bool sb_tile(const TileRegs (&cur)[NH], int kt, int tq, const bf16x8 (&q0)[NH], const bf16x8 (&q1)[NH], float (&R)[NH], f32x4 (&O)[NH][4], LAS unsigned char* vlds, int lane) {
    const int fq = lane >> 4;
    const int kb = 16 * kt + 4 * fq;
    bool valid[4];
#pragma unroll
    for (int v = 0; v < 4; ++v) valid[v] = (int)((kb + v) < tq) & (int)(kb >= 0);
    s16x4 pf[NH];
#pragma unroll
    for (int hh = 0; hh < NH; ++hh) {
        f32x4 s = {0.f, 0.f, 0.f, 0.f};
        s = __builtin_amdgcn_mfma_f32_16x16x32_bf16(cur[hh].k0, q0[hh], s, 0, 0, 0);
        s = __builtin_amdgcn_mfma_f32_16x16x32_bf16(cur[hh].k1, q1[hh], s, 0, 0, 0);
        float lk[4], ls[4];
#pragma unroll
        for (int v = 0; v < 4; ++v) { const float z = s[v] * 0.125f;
            const float sp = fmaxf(z, 0.f) + __logf(1.0f + __expf(-fabsf(z)));
            lk[v] = valid[v] ? -sp : 0.f; ls[v] = z - sp; }
        float suf[4]; suf[3] = 0.f; suf[2] = lk[3]; suf[1] = suf[2] + lk[2]; suf[0] = suf[1] + lk[1];
        const float tot = suf[0] + lk[0];
        const float t16 = pg8::xor16f(tot), t32 = pg8::xor32f(tot), t48 = pg8::xor32f(t16);
        const float higher = (((fq ^ 1) > fq) ? t16 : 0.f) + (((fq ^ 2) > fq) ? t32 : 0.f) + (((fq ^ 3) > fq) ? t48 : 0.f);
        const float bv = R[hh] + higher;
        float p[4];
#pragma unroll
        for (int v = 0; v < 4; ++v) p[v] = valid[v] ? __expf(ls[v] + bv + suf[v]) : 0.f;
        R[hh] += (tot + t16) + (t32 + t48);
        pf[hh] = pack_p(p);
    }
#pragma unroll
    for (int hh = 0; hh < NH; ++hh) pv_tile(O[hh], vlds + hh * 4096, cur[hh].v0, cur[hh].v1, pf[hh], lane);
    bool done = true;
#pragma unroll
    for (int hh = 0; hh < NH; ++hh) done = done && (R[hh] < -100.0f);
    return done;
}
__device__ __forceinline__ void sb_unit(const bf16_t* PROJ, bf16_t* ATTB, LAS unsigned char* vlds, int unit, int lane) {
    const int fr = lane & 15, fq = lane >> 4;
    const int qt = unit & 127, hp = (unit >> 7) & 1, b = unit >> 8;
    const bf16_t* base = PROJ + (size_t)b * SEQ * NIN;
    const int tq = 16 * qt + fr;
    const bf16_t* qp = base + (size_t)tq * NIN + 2304 + hp * NH * 64 + 8 * fq;
    bf16x8 q0[NH], q1[NH];
#pragma unroll
    for (int hh = 0; hh < NH; ++hh) { q0[hh] = *(const bf16x8*)(qp + 64 * hh); q1[hh] = *(const bf16x8*)(qp + 64 * hh + 32); }
    const bf16_t* kcol = base + 2560 + hp * NH * 64 + 8 * fq + (size_t)fr * NIN;
    const bf16_t* vcol = base + 2816 + hp * NH * 64 + 16 * (lane & 3) + (size_t)(lane >> 2) * NIN;
    float R[NH];
    f32x4 O[NH][4];
#pragma unroll
    for (int hh = 0; hh < NH; ++hh) { R[hh] = 0.f;
#pragma unroll
        for (int dt = 0; dt < 4; ++dt) O[hh][dt] = (f32x4){0.f, 0.f, 0.f, 0.f}; }
    int kt = qt;
    TileRegs b0[NH], b1[NH], b2[NH];
    sb_load(b0, kcol, vcol, kt);
    sb_load(b1, kcol, vcol, kt >= 1 ? kt - 1 : 0);
#pragma unroll 1
    for (;;) {
        sb_load(b2, kcol, vcol, kt >= 2 ? kt - 2 : 0);
        (void)sb_tile(b0, kt, tq, q0, q1, R, O, vlds, lane);
        sb_load(b0, kcol, vcol, kt >= 3 ? kt - 3 : 0);
        (void)sb_tile(b1, kt - 1, tq, q0, q1, R, O, vlds, lane);
        sb_load(b1, kcol, vcol, kt >= 4 ? kt - 4 : 0);
        const bool done = sb_tile(b2, kt - 2, tq, q0, q1, R, O, vlds, lane);
        kt -= 3;
        if (kt < 0 || __all(done)) break;
    }
#pragma unroll
    for (int hh = 0; hh < NH; ++hh) {
        bf16_t* op = ATTB + (size_t)(b * SEQ + tq) * 256 + (hp * NH + hh) * 64 + 4 * fq;
#pragma unroll
        for (int dt = 0; dt < 4; ++dt) { u32x2 w; w.x = pk2(O[hh][dt][0], O[hh][dt][1]); w.y = pk2(O[hh][dt][2], O[hh][dt][3]); *(u32x2*)(op + 16 * dt) = w; }
    }
}

__device__ __forceinline__ void unpack8(const u32x4 w, float (&f)[8]) { f[0] = bflo(w.x); f[1] = bfhi(w.x); f[2] = bflo(w.y); f[3] = bfhi(w.y); f[4] = bflo(w.z); f[5] = bfhi(w.z); f[6] = bflo(w.w); f[7] = bfhi(w.w); }
__device__ __forceinline__ void fixup_panel(bf16_t* G, const bf16_t* EXA, const bf16_t* EXB, const float* cw, const float* cb, int pm, int tid) {
    constexpr int C8 = DFF / 8;
    if (tid < C8) {
        const int ch = tid * 8;
        float w0[8], w1[8], w2[8], bb[8];
#pragma unroll
        for (int e = 0; e < 8; ++e) { w0[e] = cw[ch + e]; w1[e] = cw[DFF + ch + e]; w2[e] = cw[2 * DFF + ch + e]; bb[e] = cb[ch + e]; }
#pragma unroll
        for (int hp = 0; hp < 2; ++hp) {
            const int cA = 4 * pm + 2 * hp, cB = cA + 1;
            const bool first = (cA & 31) == 0;
            const u32x4 zero = {0u, 0u, 0u, 0u};
            const int cP = first ? cA : cA - 1;
            u32x4 p2 = *(const u32x4*)(EXA + ((size_t)cP * 4 + 2) * DFF + ch), p3 = *(const u32x4*)(EXA + ((size_t)cP * 4 + 3) * DFF + ch);
            const u32x4 a0 = *(const u32x4*)(EXA + ((size_t)cA * 4 + 0) * DFF + ch), a1 = *(const u32x4*)(EXA + ((size_t)cA * 4 + 1) * DFF + ch);
            const u32x4 a2 = *(const u32x4*)(EXA + ((size_t)cA * 4 + 2) * DFF + ch), a3 = *(const u32x4*)(EXA + ((size_t)cA * 4 + 3) * DFF + ch);
            const u32x4 b0 = *(const u32x4*)(EXA + ((size_t)cB * 4 + 0) * DFF + ch), b1 = *(const u32x4*)(EXA + ((size_t)cB * 4 + 1) * DFF + ch);
            const u32x4 ga0 = *(const u32x4*)(EXB + ((size_t)cA * 2 + 0) * DFF + ch), ga1 = *(const u32x4*)(EXB + ((size_t)cA * 2 + 1) * DFF + ch);
            const u32x4 gb0 = *(const u32x4*)(EXB + ((size_t)cB * 2 + 0) * DFF + ch), gb1 = *(const u32x4*)(EXB + ((size_t)cB * 2 + 1) * DFF + ch);
            if (first) { p2 = zero; p3 = zero; }
            const u32x4 cur[4] = {a0, a1, b0, b1}, m1[4] = {p3, a0, a3, b0}, m2[4] = {p2, p3, a2, a3}, gt[4] = {ga0, ga1, gb0, gb1};
#pragma unroll
            for (int k = 0; k < 4; ++k) {
                float x0[8], x1[8], x2[8], gv[8], o[8];
                unpack8(cur[k], x0); unpack8(m1[k], x1); unpack8(m2[k], x2); unpack8(gt[k], gv);
#pragma unroll
                for (int e = 0; e < 8; ++e) { const float y = w0[e] * x2[e] + w1[e] * x1[e] + w2[e] * x0[e] + bb[e]; o[e] = (y * pg8::sigmoidf_(y)) * gv[e]; }
                u32x4 w; w.x = pk2(o[0], o[1]); w.y = pk2(o[2], o[3]); w.z = pk2(o[4], o[5]); w.w = pk2(o[6], o[7]);
                const int c = (k < 2) ? cA : cB;
                *(u32x4*)(G + ((size_t)c * 64 + (k & 1)) * DFF + ch) = w;
            }
        }
    }
}

constexpr size_t WS_BAR = 983040;
#define XB_TMO      128
#define XB_XCNT(j)  (256  + 64 * (j))
#define XB_XSUB(j)  (1280 + 64 * (j))
#define XB_XGEN(j)  (2304 + 64 * (j))
#define XB_TOP      3328
#define XB_TOPGEN   3392
#define XCD_BAR_WORDS 3456
#define XB_SPIN_CAP (1u << 18)
__device__ __forceinline__ unsigned xb_ld(unsigned* p)              { return __hip_atomic_load(p, __ATOMIC_RELAXED, __HIP_MEMORY_SCOPE_AGENT); }
__device__ __forceinline__ unsigned xb_add(unsigned* p, unsigned v) { return __hip_atomic_fetch_add(p, v, __ATOMIC_RELAXED, __HIP_MEMORY_SCOPE_AGENT); }
__device__ __forceinline__ unsigned xb_xcc_id() { return (unsigned)__builtin_amdgcn_s_getreg((3 << 11) | 20) & 0xFu; }
#define XB_SPIN(cond, bar) do { unsigned _sp = 0; while (cond) { __builtin_amdgcn_s_sleep(1); \
    if ((++_sp & 255u) == 0u) { if (xb_ld(&(bar)[XB_TMO])) break; if (_sp > XB_SPIN_CAP) { atomicAdd(&(bar)[XB_TMO], 1u); break; } } } } while (0)
__device__ __forceinline__ void xcd_barrier_complete(unsigned* bar, unsigned x, unsigned& nloc, unsigned& nx) {
    const unsigned G = gridDim.x * gridDim.y * gridDim.z;
    unsigned sum, cnt, mine, sp = 0u;
    for (;;) {
        sum = 0u; cnt = 0u; mine = 0u;
#pragma unroll
        for (unsigned j = 0; j < 16; ++j) { const unsigned c = xb_ld(&bar[XB_XCNT(j)]); sum += c; cnt += (c > 0u) ? 1u : 0u; mine = (j == x) ? c : mine; }
        if (sum == G) break;
        __builtin_amdgcn_s_sleep(1);
        if ((++sp & 255u) == 0u) { if (xb_ld(&bar[XB_TMO])) break; if (sp > XB_SPIN_CAP) { atomicAdd(&bar[XB_TMO], 1u); break; } }
    }
    nloc = mine > 0u ? mine : 1u; nx = cnt > 0u ? cnt : 1u;
}
__device__ __forceinline__ void grid_bar(unsigned* bar, unsigned x, volatile LAS unsigned* st, int wave_s) {
    asm volatile("s_waitcnt vmcnt(0)" ::: "memory");
    __syncthreads();
    if (wave_s == 0) {
      if (pg8::lane_id_asm() == 0) {
        __builtin_amdgcn_s_waitcnt(0);
        unsigned nloc = st[0], nx = st[1];
        if (nloc == 0u) { xcd_barrier_complete(bar, x, nloc, nx); st[0] = nloc; st[1] = nx; }
        const unsigned old = xb_add(&bar[XB_XSUB(x)], 1u);
        const unsigned gen = old / nloc;
        if (old + 1u == (gen + 1u) * nloc) {
            __builtin_amdgcn_fence(__ATOMIC_RELEASE, "agent");
            asm volatile("s_waitcnt vmcnt(0)" ::: "memory");
            const unsigned og = xb_add(&bar[XB_TOP], 1u);
            const unsigned tg = og / nx;
            if (og + 1u == (tg + 1u) * nx) xb_add(&bar[XB_TOPGEN], 1u);
            else XB_SPIN(xb_ld(&bar[XB_TOPGEN]) == tg, bar);
            __builtin_amdgcn_fence(__ATOMIC_ACQUIRE, "agent");
            xb_add(&bar[XB_XGEN(x)], 1u);
            asm volatile("s_waitcnt vmcnt(0)" ::: "memory");
        } else {
            XB_SPIN(xb_ld(&bar[XB_XGEN(x)]) == gen, bar);
            __builtin_amdgcn_fence(__ATOMIC_ACQUIRE, "agent");
            asm volatile("s_waitcnt vmcnt(0)" ::: "memory");
        }
      }
    }
    __syncthreads();
}
__global__ void __launch_bounds__(NWAVES * 64, 2) mk_fwd(Args a) {
    extern __shared__ __attribute__((aligned(16))) unsigned char lds_raw[];
    LAS unsigned char* lds = (LAS unsigned char*)lds_raw;
    const int wave_s = __builtin_amdgcn_readfirstlane((int)threadIdx.x >> 6);
    const int G = gridDim.x, bx = blockIdx.x, ngw = G * NWAVES, nthr = G * NWAVES * 64;
    volatile LAS unsigned* bst = (volatile LAS unsigned*)(lds + 131072 + 256);
    const unsigned xcc = xb_xcc_id();
    if (threadIdx.x == 0) { bst[0] = 0u; bst[1] = 0u; (void)xb_add((unsigned*)(a.ws + WS_BAR) + XB_XCNT(xcc), 1u); }
    {
        cg::grid_group grid = cg::this_grid();
        const int tid = threadIdx.x, lane = tid & 63, gw = bx * NWAVES + wave_s, gtid = bx * (NWAVES * 64) + tid;
        float* SS = (float*)(a.ws + WS_SS); float* ROPE = (float*)(a.ws + WS_ROPE); bf16_t* XB = (bf16_t*)(a.ws + WS_XB);
        convert_layer(a, 0, lds, gw, ngw, wave_s, lane);
        for (int row = gw; row < M; row += ngw) {
            const f32x4* xr = (const f32x4*)(a.x + (size_t)row * D) + lane; float s = 0.f;
            unsigned long long* o8 = (unsigned long long*)(XB + (size_t)row * D) + lane;
#pragma unroll
            for (int j = 0; j < 4; ++j) { const f32x4 v = xr[64 * j]; s += (v[0] * v[0] + v[1] * v[1]) + (v[2] * v[2] + v[3] * v[3]);
                o8[64 * j] = (unsigned long long)pk2(v[0], v[1]) | ((unsigned long long)pk2(v[2], v[3]) << 32); }
            s = wave_sum(s);
            if (lane < 16) SS[(size_t)row * 16 + lane] = (lane == 0) ? s : 0.f;
        }
        for (int i = gtid; i < 8 * M; i += nthr) {
            const int row = i >> 3, e = i & 7;
            const float angf = (float)a.pos[row] * a.inv_freq[e];
            const double x = (double)angf, n = rint(x * 0.15915494309189535), rr = fma(-n, 2.4492935982947064e-16, fma(-n, 6.283185307179586, x)), r2 = rr * rr;
            double sn = 1.0, cs = 1.0;
#pragma unroll
            for (int k = 13; k >= 1; --k) { sn = 1.0 - sn * r2 * (1.0 / (double)((2 * k) * (2 * k + 1))); cs = 1.0 - cs * r2 * (1.0 / (double)((2 * k - 1) * (2 * k))); }
            ROPE[row * 16 + e] = (float)cs; ROPE[row * 16 + 8 + e] = (float)(rr * sn);
        }
        grid.sync();
    }
#ifndef PROBE_BAR
#define PROBE_BAR 1
#endif
#ifndef PROBE_ATT
#define PROBE_ATT 1
#endif
#ifndef PROBE_G1
#define PROBE_G1 1
#endif
#ifndef PROBE_G4
#define PROBE_G4 1
#endif
#ifndef PROBE_DIL
#define PROBE_DIL 1
#endif
#ifndef PROBE_SB
#define PROBE_SB 1
#endif
#ifndef PROBE_CONV
#define PROBE_CONV 1
#endif
#ifndef PROBE_G2
#define PROBE_G2 1
#endif
#define GRID_BAR() do { for (int rb_ = 0; rb_ < PROBE_BAR; ++rb_) { grid_bar((unsigned*)(a.ws + WS_BAR), xcc, bst, wave_s); } } while (0)

#pragma unroll 1
    for (int l = 0; l < DEPTH; ++l) {
        for (int rp_ = 0; rp_ < PROBE_G1; ++rp_) { size_t z_ = 0; asm volatile("" : "+s"(z_)); unsigned char* ws = a.ws + z_; float* outp = a.out + z_; const float* xin = a.x + z_;     unsigned char* set = ws + WS_W + (size_t)(l & 1) * W_SET;
          const float* bg_ = a.b_gate + l * 2 * D + z_;
          pg8::Gemm g{(const bf16_t*)(ws + WS_XB), (const bf16_t*)(set + W_IN), M, NIN, D}; pg8::StaticOrder S; S.init(M, NIN, G, bx);
          pg8::EpiProj E{(bf16_t*)(ws + WS_PROJ), (const float*)(ws + WS_SS) + (size_t)(2 * l) * M * 16, (const float*)(ws + WS_ROPE), bg_, (LAS float*)(lds + 131072 + 1024) + wave_s * 128, -1};
          pg8::gemm_phase<pg8::EpiProj, pg8::StaticOrder, true, true>(lds, g, S, E, wave_s); }
        GRID_BAR();
        for (int rp_ = 0; rp_ < PROBE_ATT; ++rp_) { size_t z_ = 0; asm volatile("" : "+s"(z_)); unsigned char* ws = a.ws + z_; float* outp = a.out + z_; const float* xin = a.x + z_;
          const int vbx_ = (G % 8 == 0) ? (bx % 8) * (G / 8) + bx / 8 : bx;
          const int lane_ = pg8::lane_id_asm(), gw_ = vbx_ * NWAVES + wave_s;
          LAS unsigned char* vlds = lds + wave_s * 16384;
          for (int rd_ = 0; rd_ < PROBE_DIL; ++rd_) for (int u = vbx_; u < 256; u += G) dil_block((const bf16_t*)(ws + WS_PROJ), (bf16_t*)(ws + WS_ATTA), lds, u, wave_s, lane_);
          for (int rs_ = 0; rs_ < PROBE_SB; ++rs_) for (int u = gw_; u < 4096 / NH; u += ngw) sb_unit((const bf16_t*)(ws + WS_PROJ), (bf16_t*)(ws + WS_ATTB), vlds, u, lane_);
        }
        GRID_BAR();
        { size_t z_ = 0; asm volatile("" : "+s"(z_)); unsigned char* ws = a.ws + z_; float* outp = a.out + z_; const float* xin = a.x + z_;     unsigned char* set = ws + WS_W + (size_t)(l & 1) * W_SET;
          pg8::Gemm g{(const bf16_t*)(ws + WS_ATTA), (const bf16_t*)(set + W_PA), M, D, 256}; pg8::StaticOrder S; S.init(M, D, G, bx);
          pg8::EpiGate<0> E{(bf16_t*)(ws + WS_MIX), (const bf16_t*)(ws + WS_PROJ)};
          pg8::gemm_phase<pg8::EpiGate<0>, pg8::StaticOrder, true, true>(lds, g, S, E, wave_s); }
        { size_t z_ = 0; asm volatile("" : "+s"(z_)); unsigned char* ws = a.ws + z_; float* outp = a.out + z_; const float* xin = a.x + z_;     unsigned char* set = ws + WS_W + (size_t)(l & 1) * W_SET;
          pg8::Gemm g{(const bf16_t*)(ws + WS_ATTB), (const bf16_t*)(set + W_PB), M, D, 256}; pg8::StaticOrder S; S.init(M, D, G, bx);
          pg8::EpiGate<1> E{(bf16_t*)(ws + WS_MIX), (const bf16_t*)(ws + WS_PROJ)};
          pg8::gemm_phase<pg8::EpiGate<1>, pg8::StaticOrder, true, true>(lds, g, S, E, wave_s); }
        GRID_BAR();
        { size_t z_ = 0; asm volatile("" : "+s"(z_)); unsigned char* ws = a.ws + z_; float* outp = a.out + z_; const float* xin = a.x + z_;     unsigned char* set = ws + WS_W + (size_t)(l & 1) * W_SET;
          pg8::Gemm g{(const bf16_t*)(ws + WS_MIX), (const bf16_t*)(set + W_OUT), M, D, D}; pg8::StaticOrder S; S.init(M, D, G, bx);
          pg8::EpiResid E{l == 0 ? xin : outp, outp, (bf16_t*)(ws + WS_XB), (float*)(ws + WS_SS) + (size_t)(2 * l + 1) * M * 16};
          pg8::gemm_phase<pg8::EpiResid, pg8::StaticOrder, true, true>(lds, g, S, E, wave_s); }
        GRID_BAR();
        for (int rp_ = 0; rp_ < PROBE_G4; ++rp_) { size_t z_ = 0; asm volatile("" : "+s"(z_)); unsigned char* ws = a.ws + z_; unsigned char* set = ws + WS_W + (size_t)(l & 1) * W_SET;
          const float* cw_ = a.conv_w + (size_t)l * 3 * DFF + z_; const float* cb_ = a.conv_b + (size_t)l * DFF + z_;
          pg8::Gemm g{(const bf16_t*)(ws + WS_XB), (const bf16_t*)(set + W_UP), M, NUP, D}; pg8::StaticOrder S; S.init(M, NUP, G, bx);
          pg8::EpiUpConv E{(bf16_t*)(ws + WS_G), (bf16_t*)(ws + WS_EXA), (bf16_t*)(ws + WS_EXB), (const float*)(ws + WS_SS) + (size_t)(2 * l + 1) * M * 16, cw_, cb_, (LAS float*)(lds + 131072 + 1024) + wave_s * 128, -1};
          pg8::gemm_phase<pg8::EpiUpConv, pg8::StaticOrder, true, true>(lds, g, S, E, wave_s);
          if (l + 1 < DEPTH) {
              const int nun = (M / 256) * (NUP / 256), rem = nun % G, lane_ = pg8::lane_id_asm();
              for (int rc_ = 0; rc_ < PROBE_CONV; ++rc_) {
                  if (rem == 0) convert_layer(a, l + 1, lds, bx * NWAVES + wave_s, ngw, wave_s, lane_);
                  else if (bx >= rem) convert_layer(a, l + 1, lds, (bx - rem) * NWAVES + wave_s, (G - rem) * NWAVES, wave_s, lane_);
              } } }
        GRID_BAR();
        { size_t z_ = 0; asm volatile("" : "+s"(z_)); unsigned char* ws = a.ws + z_; float* outp = a.out + z_; const float* xin = a.x + z_;     unsigned char* set = ws + WS_W + (size_t)(l & 1) * W_SET;
          pg8::Gemm g{(const bf16_t*)(ws + WS_G), (const bf16_t*)(set + W_DN), M, D, DFF}; pg8::StaticOrder S; S.init(M, D, G, bx);
          { const float* cw_ = a.conv_w + (size_t)l * 3 * DFF + z_; const float* cb_ = a.conv_b + (size_t)l * DFF + z_;
            const int tid_ = wave_s * 64 + pg8::lane_id_asm(); pg8::Unit fu;
            for (int i = 0; S.next(i, fu); ++i) fixup_panel((bf16_t*)(ws + WS_G), (const bf16_t*)(ws + WS_EXA), (const bf16_t*)(ws + WS_EXB), cw_, cb_, fu.pm, tid_);
            asm volatile("s_waitcnt vmcnt(0)" ::: "memory"); __syncthreads(); }
          pg8::EpiResid E{outp, outp, (bf16_t*)(ws + WS_XB), (float*)(ws + WS_SS) + (size_t)(2 * l + 2) * M * 16};
          pg8::gemm_phase<pg8::EpiResid, pg8::StaticOrder, true, true>(lds, g, S, E, wave_s); }
        GRID_BAR();
    }
    { const int lanef = pg8::lane_id_asm(), gwf = bx * NWAVES + wave_s;
      const float* SS8 = (const float*)(a.ws + WS_SS) + (size_t)8 * M * 16;
      for (int row = gwf; row < M; row += ngw) {
        float ssv = SS8[(size_t)row * 16 + (lanef & 15)]; ssv += __shfl_xor(ssv, 1); ssv += __shfl_xor(ssv, 2); ssv += __shfl_xor(ssv, 4); ssv += __shfl_xor(ssv, 8);
        const float rs = rsqrtf(ssv * (1.0f / 1024.0f) + 1e-5f);
        f32x4* xr = (f32x4*)(a.out + (size_t)row * D) + lanef; const f32x4* gr = (const f32x4*)a.norm_final + lanef;
#pragma unroll
        for (int j = 0; j < 4; ++j) { const f32x4 v = xr[64 * j], gg = gr[64 * j]; xr[64 * j] = v * rs * gg; }
      } }
}

extern "C" void kernel_launch(void* const* d_in, const int* in_sizes, int n_in, void* d_out, int out_size, void* d_ws, size_t ws_size, hipStream_t stream) {
    static int grid = 0;
    if (grid == 0) {
        if (n_in != 14 || in_sizes[0] != M * D || out_size != M * D || ws_size < WS_END) { fprintf(stderr, "kernel_launch: unexpected shapes (n_in %d, in0 %d, out %d, ws %zu)\n", n_in, n_in > 0 ? in_sizes[0] : -1, out_size, ws_size); grid = -1; return; }
        int dev = 0, cus = 0, per_cu = 0;
        (void)hipGetDevice(&dev); (void)hipDeviceGetAttribute(&cus, hipDeviceAttributeMultiprocessorCount, dev);
        if (hipFuncSetAttribute((const void*)mk_fwd, hipFuncAttributeMaxDynamicSharedMemorySize, LDS_BYTES) != hipSuccess) { fprintf(stderr, "kernel_launch: hipFuncSetAttribute failed\n"); grid = -1; return; }
        if (hipOccupancyMaxActiveBlocksPerMultiprocessor(&per_cu, (const void*)mk_fwd, NWAVES * 64, LDS_BYTES) != hipSuccess || per_cu < 1) { fprintf(stderr, "kernel_launch: occupancy query says %d\n", per_cu); per_cu = 1; }
        (void)hipGetLastError();
        grid = cus * per_cu;
    }
    if (grid < 0) return;
    Args a{};
    a.x = (const float*)d_in[0]; a.pos = (const int*)d_in[1]; a.norm_mix = (const float*)d_in[2]; a.w_in = (const float*)d_in[3]; a.b_gate = (const float*)d_in[4];
    a.w_proj_a = (const float*)d_in[5]; a.w_proj_b = (const float*)d_in[6]; a.w_out = (const float*)d_in[7]; a.norm_ffn = (const float*)d_in[8]; a.w_up = (const float*)d_in[9];
    a.conv_w = (const float*)d_in[10]; a.conv_b = (const float*)d_in[11]; a.w_down = (const float*)d_in[12]; a.norm_final = (const float*)d_in[13];
    a.out = (float*)d_out; a.ws = (unsigned char*)d_ws;
    for (int i = 0; i < 8; ++i) a.inv_freq[i] = (float)pow(500000.0, -(double)i / 8.0);
    if (hipMemsetAsync((unsigned char*)d_ws + WS_BAR, 0, 16384, stream) != hipSuccess) { fprintf(stderr, "kernel_launch: memset failed\n"); return; }
    void* args[] = {&a};
    const hipError_t e = hipLaunchCooperativeKernel((const void*)mk_fwd, dim3(grid), dim3(NWAVES * 64), args, LDS_BYTES, stream);
    if (e != hipSuccess) fprintf(stderr, "kernel_launch: cooperative launch failed: %s (grid %d)\n", hipGetErrorString(e), grid);
}
```

```cpp
#include <hip/hip_runtime.h>
#include <hip/hip_cooperative_groups.h>
#include <cstdio>
#include <cstdint>
#include <cmath>
namespace cg = cooperative_groups;
namespace pg8 {
#define PG8_LAS __attribute__((address_space(3)))
typedef unsigned short bf16_t;
typedef short bf16x8 __attribute__((ext_vector_type(8)));
typedef float f32x4 __attribute__((ext_vector_type(4)));
typedef unsigned u32x4 __attribute__((ext_vector_type(4)));
constexpr int BM = 256, BK = 64, HALF = 128, HTB = HALF * BK * 2  , STAGE_BYTES = 8 * HTB, NXCD = 8, WGM = 8;

__host__ __device__ __forceinline__ int lds_byte(int r, int c) { const int st = (r >> 4) * 2 + (c >> 5), rr = r & 15, cc = c & 31, ob = rr * 64 + cc * 2; return st * 1024 + (ob ^ (((ob >> 9) & 1) << 5)); }
__host__ __device__ __forceinline__ void stage_rc(int b, int& R, int& C) { const int st = b / 1024, sb = b % 1024, swz = sb ^ (((sb >> 9) & 1) << 5); R = (st >> 1) * 16 + swz / 64; C = (st & 1) * 32 + (swz % 64) / 2; }
__host__ __device__ __forceinline__ int perm32(int rho) { const int n = rho >> 4, i = rho & 15; return 8 * (i >> 2) + 4 * n + (i & 3); }

struct Unit { int pm, pn; };
struct Gemm { const bf16_t* A; const bf16_t* Bt; int M, N, K; };

struct StaticOrder {
    int nM, nN, nwg, G, c;
    __host__ __device__ void init(int M, int N, int G_, int c_) { nM = M / BM; nN = N / BM; nwg = nM * nN; G = G_; c = c_; }
    __host__ __device__ bool next(int i, Unit& u) const {
        const long L = (long)i * G + c; if (L >= nwg) return false;
        int wgid = (int)L; { const int q = nwg / NXCD, r = nwg % NXCD, xcd = wgid % NXCD, off = wgid / NXCD; wgid = (xcd < r ? xcd * (q + 1) : r * (q + 1) + (xcd - r) * q) + off; }
        const int nig = WGM * nN, gid = wgid / nig, fm = gid * WGM, gsz = (nM - fm) < WGM ? (nM - fm) : WGM;
        u.pm = fm + ((wgid % nig) % gsz); u.pn = (wgid % nig) / gsz; return true;
    }
    __device__ __forceinline__ void a_ready(const Unit&) const {}
    __device__ __forceinline__ void done(const Unit&) const {}
};

__device__ __forceinline__ unsigned cvt_pk_bf16(float lo, float hi) { unsigned r; asm volatile("v_cvt_pk_bf16_f32 %0, %1, %2" : "=v"(r) : "v"(lo), "v"(hi)); return r; }
typedef float f32x2 __attribute__((ext_vector_type(2)));
__device__ __forceinline__ int lane_id_asm() { int l; asm volatile("v_mbcnt_lo_u32_b32 %0, -1, 0\n\tv_mbcnt_hi_u32_b32 %0, -1, %0" : "=v"(l)); return l; }
__device__ __forceinline__ float xor16f(float x) { return __int_as_float(__builtin_amdgcn_ds_swizzle(__float_as_int(x), 0x401F)); }
__device__ __forceinline__ float xor32f(float x) { const unsigned xi = __float_as_uint(x); auto rr = __builtin_amdgcn_permlane32_swap(xi, xi, false, false); return __uint_as_float(rr[0] == xi ? rr[1] : rr[0]); }
__device__ __forceinline__ float max32f(float x) { const unsigned xi = __float_as_uint(x); auto rr = __builtin_amdgcn_permlane32_swap(xi, xi, false, false); return fmaxf(__uint_as_float(rr[0]), __uint_as_float(rr[1])); }
__device__ __forceinline__ float bf_lo(unsigned w) { return __uint_as_float(w << 16); }
__device__ __forceinline__ float bf_hi(unsigned w) { return __uint_as_float(w & 0xffff0000u); }
__device__ __forceinline__ f32x4 ld_ss4(const float* ssp, int row, int fq) { return *(const f32x4*)(ssp + (size_t)row * 16 + 4 * fq); }
__device__ __forceinline__ float red_ss4(const f32x4 a) { float s = (a[0] + a[1]) + (a[2] + a[3]); s += xor16f(s); s += xor32f(s); return s; }
__device__ __forceinline__ u32x4 pack8(const f32x4 v0, const f32x4 v1) { u32x4 w; w.x = cvt_pk_bf16(v0[0], v0[1]); w.y = cvt_pk_bf16(v0[2], v0[3]); w.z = cvt_pk_bf16(v1[0], v1[1]); w.w = cvt_pk_bf16(v1[2], v1[3]); return w; }
__device__ __forceinline__ float sigmoidf_(float x) { return __builtin_amdgcn_rcpf(1.0f + __builtin_amdgcn_exp2f(x * -1.4426950408889634f)); }

struct EpiProj {
    static constexpr bool PERM = true, AFTER_DRAIN = false;
    bf16_t* O; const float* ss; const float* rope; const float* bgate; PG8_LAS float* rsc; mutable int cached_pm;
    __device__ __forceinline__ void operator()(const f32x4 (&acc)[2][2][4][2], const Unit& u, int wr, int wc, int fr_, int fq_) const {
        const int ln_ = lane_id_asm(), fr = ln_ & 15, fq = ln_ >> 4;
        const int row0 = u.pm * BM + wr * 64 + fr, col0 = u.pn * BM + wc * 32 + 8 * fq;
        const bool is_rope = (u.pn < 6) && ((wc & 1) == 0);
        const bool is_gate = (u.pn >= 12);
        float rs[8];
        const bool fresh = (u.pm != cached_pm);
        if (fresh) {
            f32x4 pr[8];
#pragma unroll
            for (int i = 0; i < 8; ++i) pr[i] = ld_ss4(ss, row0 + (i >> 2) * HALF + (i & 3) * 16, fq);
#pragma unroll
            for (int i = 0; i < 8; ++i) rs[i] = red_ss4(pr[i]);
        }
        f32x4 gb[2][2];
#pragma unroll
        for (int bj = 0; bj < 2; ++bj) { gb[bj][0] = (f32x4){0.f, 0.f, 0.f, 0.f}; gb[bj][1] = gb[bj][0];
            if (is_gate) { gb[bj][0] = *(const f32x4*)(bgate + col0 + bj * HALF - 3072); gb[bj][1] = *(const f32x4*)(bgate + col0 + bj * HALF - 3072 + 4); } }
        if (fresh) {
#pragma unroll
            for (int i = 0; i < 8; ++i) { rs[i] = rsqrtf(rs[i] * (1.0f / 1024.0f) + 1e-5f); if (fq == 0) rsc[i * 16 + fr] = rs[i]; }
            cached_pm = u.pm;
        } else {
#pragma unroll
            for (int i = 0; i < 8; ++i) rs[i] = rsc[i * 16 + fr];
        }
#pragma unroll
        for (int ai2 = 0; ai2 < 4; ++ai2) {
            const int ai = ai2 >> 1;
            f32x4 rc[4][4];
            if (is_rope) {
#pragma unroll
                for (int m = (ai2 & 1) * 2; m < (ai2 & 1) * 2 + 2; ++m) { const float* rp = rope + (size_t)(row0 + ai * HALF + m * 16) * 16;
                    rc[m][0] = *(const f32x4*)rp; rc[m][1] = *(const f32x4*)(rp + 4); rc[m][2] = *(const f32x4*)(rp + 8); rc[m][3] = *(const f32x4*)(rp + 12); }
            }
#pragma unroll
            for (int m = (ai2 & 1) * 2; m < (ai2 & 1) * 2 + 2; ++m) {
                const int row = row0 + ai * HALF + m * 16;
                const float r = rs[ai * 4 + m];
#pragma unroll
                for (int bj = 0; bj < 2; ++bj) {
                    f32x4 v0 = acc[ai][bj][m][0] * r, v1 = acc[ai][bj][m][1] * r;
                    const int col = col0 + bj * HALF;
                    if (is_rope) {
                        f32x4 o0, o1;
#pragma unroll
                        for (int i = 0; i < 4; ++i) { o0[i] = xor16f(v0[i]); o1[i] = xor16f(v1[i]); }
                        if (fq == 0) { v0 = v0 * rc[m][0] - o0 * rc[m][2]; v1 = v1 * rc[m][1] - o1 * rc[m][3]; }
                        else if (fq == 1) { v0 = v0 * rc[m][0] + o0 * rc[m][2]; v1 = v1 * rc[m][1] + o1 * rc[m][3]; }
                    }
                    if (is_gate) {
#pragma unroll
                        for (int i = 0; i < 4; ++i) { v0[i] = sigmoidf_(v0[i] + gb[bj][0][i]); v1[i] = sigmoidf_(v1[i] + gb[bj][1][i]); }
                    }
                    *(u32x4*)(O + (size_t)row * 5120 + col) = pack8(v0, v1);
                }
            }
        }
    }
};
struct EpiUpConv {
    static constexpr bool PERM = true, AFTER_DRAIN = false;
    bf16_t* Gout; bf16_t* EXA; bf16_t* EXB; const float* ss; const float* cw; const float* cb; PG8_LAS float* rsc; mutable int cached_pm;
    __device__ __forceinline__ void operator()(const f32x4 (&acc)[2][2][4][2], const Unit& u, int wr, int wc, int fr_, int fq_) const {
        const int ln_ = lane_id_asm(), fr = ln_ & 15, fq = ln_ >> 4;
        const int ch0 = u.pn * 128 + wc * 32 + 8 * fq, row0 = u.pm * BM + wr * 64 + fr;
        float rs[8];
        const bool fresh = (u.pm != cached_pm);
        if (fresh) {
            f32x4 pr[8];
#pragma unroll
            for (int i = 0; i < 8; ++i) pr[i] = ld_ss4(ss, row0 + (i >> 2) * HALF + (i & 3) * 16, fq);
#pragma unroll
            for (int i = 0; i < 8; ++i) rs[i] = red_ss4(pr[i]);
        }
        f32x4 w0[2], w1[2], w2[2], wb[2];
#pragma unroll
        for (int n = 0; n < 2; ++n) { w0[n] = *(const f32x4*)(cw + ch0 + 4 * n); w1[n] = *(const f32x4*)(cw + 2816 + ch0 + 4 * n); w2[n] = *(const f32x4*)(cw + 5632 + ch0 + 4 * n); wb[n] = *(const f32x4*)(cb + ch0 + 4 * n); }
        if (fresh) {
#pragma unroll
            for (int i = 0; i < 8; ++i) { rs[i] = rsqrtf(rs[i] * (1.0f / 1024.0f) + 1e-5f); if (fq == 0) rsc[i * 16 + fr] = rs[i]; }
            cached_pm = u.pm;
        } else {
#pragma unroll
            for (int i = 0; i < 8; ++i) rs[i] = rsc[i * 16 + fr];
        }
        const int sl1 = ((ln_ & 48) | ((fr + 15) & 15)) << 2, sl2 = ((ln_ & 48) | ((fr + 14) & 15)) << 2;
#pragma unroll
        for (int ai = 0; ai < 2; ++ai) {
            const int chunk = 4 * u.pm + 2 * ai + wr;
            f32x4 s1p[2], s2p[2];
            s1p[0] = (f32x4){0.f, 0.f, 0.f, 0.f}; s1p[1] = s1p[0]; s2p[0] = s1p[0]; s2p[1] = s1p[0];
#pragma unroll
            for (int m = 0; m < 4; ++m) {
                const float r = rs[ai * 4 + m];
                f32x4 av[2], bv[2], g[2];
#pragma unroll
                for (int n = 0; n < 2; ++n) {
                    av[n] = acc[ai][0][m][n] * r; bv[n] = acc[ai][1][m][n] * r;
                    f32x4 s1, s2;
#pragma unroll
                    for (int e = 0; e < 4; ++e) { s1[e] = __int_as_float(__builtin_amdgcn_update_dpp(0, __float_as_int(av[n][e]), 0x121, 0xf, 0xf, false));
                                                  s2[e] = __int_as_float(__builtin_amdgcn_update_dpp(0, __float_as_int(av[n][e]), 0x122, 0xf, 0xf, false)); }
                    const f32x4 p1 = (fr == 0) ? s1p[n] : s1, p2 = (fr < 2) ? s2p[n] : s2;
                    s1p[n] = s1; s2p[n] = s2;
#pragma unroll
                    for (int e = 0; e < 4; ++e) { const float y = fmaf(w0[n][e], p2[e], fmaf(w1[n][e], p1[e], fmaf(w2[n][e], av[n][e], wb[n][e])));
                        g[n][e] = (y * sigmoidf_(y)) * bv[n][e]; }
                }
                const int row = row0 + ai * HALF + m * 16;
                if (m == 0 && fr < 2) {
                    *(u32x4*)(EXA + ((size_t)chunk * 4 + fr) * 2816 + ch0) = pack8(av[0], av[1]);
                    *(u32x4*)(EXB + ((size_t)chunk * 2 + fr) * 2816 + ch0) = pack8(bv[0], bv[1]);
                } else {
                    *(u32x4*)(Gout + (size_t)row * 2816 + ch0) = pack8(g[0], g[1]);
                    if (m == 3 && fr >= 14) *(u32x4*)(EXA + ((size_t)chunk * 4 + 2 + (fr - 14)) * 2816 + ch0) = pack8(av[0], av[1]);
                }
            }
        }
    }
};
template <int MODE> struct EpiGate {
    static constexpr bool PERM = true, AFTER_DRAIN = false;
    bf16_t* MIX; const bf16_t* PROJ;
    __device__ __forceinline__ void operator()(const f32x4 (&acc)[2][2][4][2], const Unit& u, int wr, int wc, int fr_, int fq_) const {
        const int ln_ = lane_id_asm(), fr = ln_ & 15, fq = ln_ >> 4;
        const int row0 = u.pm * BM + wr * 64 + fr, col0 = u.pn * BM + wc * 32 + 8 * fq;
#pragma unroll
        for (int ai = 0; ai < 2; ++ai) {
            u32x4 g[4][2], o[4][2];
#pragma unroll
            for (int m = 0; m < 4; ++m)
#pragma unroll
                for (int bj = 0; bj < 2; ++bj) { const int row = row0 + ai * HALF + m * 16, col = col0 + bj * HALF;
                    g[m][bj] = *(const u32x4*)(PROJ + (size_t)row * 5120 + (MODE == 0 ? 3072 : 4096) + col);
                    if (MODE == 1) o[m][bj] = *(const u32x4*)(MIX + (size_t)row * 1024 + col); }
#pragma unroll
            for (int m = 0; m < 4; ++m)
#pragma unroll
                for (int bj = 0; bj < 2; ++bj) { const int row = row0 + ai * HALF + m * 16, col = col0 + bj * HALF;
                    const f32x4 a0 = acc[ai][bj][m][0], a1 = acc[ai][bj][m][1]; const u32x4 gg = g[m][bj];
                    f32x4 v0 = {bf_lo(gg.x) * a0[0], bf_hi(gg.x) * a0[1], bf_lo(gg.y) * a0[2], bf_hi(gg.y) * a0[3]};
                    f32x4 v1 = {bf_lo(gg.z) * a1[0], bf_hi(gg.z) * a1[1], bf_lo(gg.w) * a1[2], bf_hi(gg.w) * a1[3]};
                    if (MODE == 1) { const u32x4 oo = o[m][bj];
                        v0 += (f32x4){bf_lo(oo.x), bf_hi(oo.x), bf_lo(oo.y), bf_hi(oo.y)}; v1 += (f32x4){bf_lo(oo.z), bf_hi(oo.z), bf_lo(oo.w), bf_hi(oo.w)}; }
                    *(u32x4*)(MIX + (size_t)row * 1024 + col) = pack8(v0, v1); }
        }
    }
};
struct EpiResid {
    static constexpr bool PERM = true, AFTER_DRAIN = false;
    const float* base; float* out; bf16_t* XB; float* ss;
    __device__ __forceinline__ void operator()(const f32x4 (&acc)[2][2][4][2], const Unit& u, int wr, int wc, int fr_, int fq_) const {
        const int ln_ = lane_id_asm(), fr = ln_ & 15, fq = ln_ >> 4;
        const int row0 = u.pm * BM + wr * 64 + fr, col0 = u.pn * BM + wc * 32 + 8 * fq;
#pragma unroll
        for (int ai2 = 0; ai2 < 4; ++ai2) {
            const int ai = ai2 >> 1;
            f32x4 b[4][2][2];
#pragma unroll
            for (int m = (ai2 & 1) * 2; m < (ai2 & 1) * 2 + 2; ++m)
#pragma unroll
                for (int bj = 0; bj < 2; ++bj) { const size_t off = (size_t)(row0 + ai * HALF + m * 16) * 1024 + col0 + bj * HALF; b[m][bj][0] = *(const f32x4*)(base + off); b[m][bj][1] = *(const f32x4*)(base + off + 4); }
#pragma unroll
            for (int m = (ai2 & 1) * 2; m < (ai2 & 1) * 2 + 2; ++m) {
                const int row = row0 + ai * HALF + m * 16; float part = 0.f;
#pragma unroll
                for (int bj = 0; bj < 2; ++bj) {
                    const size_t off = (size_t)row * 1024 + col0 + bj * HALF;
                    const f32x4 v0 = b[m][bj][0] + acc[ai][bj][m][0], v1 = b[m][bj][1] + acc[ai][bj][m][1];
                    *(f32x4*)(out + off) = v0; *(f32x4*)(out + off + 4) = v1;
                    *(u32x4*)(XB + off) = pack8(v0, v1);
                    part += (v0[0] * v0[0] + v0[1] * v0[1]) + (v0[2] * v0[2] + v0[3] * v0[3]) + (v1[0] * v1[0] + v1[1] * v1[1]) + (v1[2] * v1[2] + v1[3] * v1[3]);
                }
                part += xor16f(part); part += xor32f(part);
                if (fq == 0) ss[(size_t)row * 16 + u.pn * 4 + wc] = part;
            }
        }
    }
};
template <class Epi, class Sched, bool ALIGN_EPI = false, bool SP2 = false>
__device__ __forceinline__ void gemm_phase(PG8_LAS unsigned char* lds, const Gemm g, const Sched& S, const Epi& E, const int wave_s) {
    int wv_ = wave_s; asm volatile("" : "+s"(wv_)); const int lane_ = lane_id_asm(); const int tid = wv_ * 64 + lane_, wid = wv_, lane = tid & 63, wr = wid >> 2, wc = wid & 3, fr = lane & 15, fq = lane >> 4;
    const int K = g.K, nt = K / BK;
    unsigned voffA[2], voffB[2];
#pragma unroll
    for (int i = 0; i < 2; ++i) { int R, C; stage_rc(tid * 16 + i * 8192, R, C); const int Rb = Epi::PERM ? ((R & ~31) + perm32(R & 31)) : R;
        voffA[i] = (unsigned)(R * K + C) * 2u; voffB[i] = (unsigned)(Rb * K + C) * 2u; }
    const size_t kstep = (size_t)(BK * 2);
    const size_t hstep = (size_t)HALF * K * 2;
    const size_t tstep = 2 * hstep;
    const unsigned ldsw = (unsigned)wid * 1024u;
    const int aoff = lds_byte(wr * 64 + fr, fq * 8), boff = lds_byte(wc * 32 + fr, fq * 8);
#define PG8_SA(b, h) (((b) * 2 + (h)) * HTB)
#define PG8_SB(b, h) ((4 + (b) * 2 + (h)) * HTB)
#define PG8_STAGE(bufoff, gbase, voff) do { _Pragma("unroll") for (int _i = 0; _i < 2; ++_i) \
        __builtin_amdgcn_global_load_lds((const unsigned*)((const char*)(gbase) + (voff)[_i]), (PG8_LAS unsigned*)(lds + (bufoff) + ldsw + _i * 8192), 16, 0, 0); } while (0)
#define PG8_LDA(dst, b, h) do { _Pragma("unroll") for (int m = 0; m < 4; ++m) _Pragma("unroll") for (int k = 0; k < 2; ++k) dst[m][k] = *(const PG8_LAS bf16x8*)(lds + PG8_SA(b, h) + aoff + m * 2048 + k * 1024); } while (0)
#define PG8_LDB(dst, b, h) do { _Pragma("unroll") for (int n = 0; n < 2; ++n) _Pragma("unroll") for (int k = 0; k < 2; ++k) dst[n][k] = *(const PG8_LAS bf16x8*)(lds + PG8_SB(b, h) + boff + n * 2048 + k * 1024); } while (0)
#define PG8_MMA(ai, bj, At, Bt) do { __builtin_amdgcn_s_setprio(1); _Pragma("unroll") for (int m = 0; m < 4; ++m) _Pragma("unroll") for (int n = 0; n < 2; ++n) _Pragma("unroll") for (int k = 0; k < 2; ++k) \
        acc[ai][bj][m][n] = __builtin_amdgcn_mfma_f32_16x16x32_bf16(Bt[n][k], At[m][k], acc[ai][bj][m][n], 0, 0, 0); __builtin_amdgcn_s_setprio(0); } while (0)
#define PG8_WAIT_V(n) asm volatile("s_waitcnt vmcnt(" #n ")" ::: "memory")
#define PG8_WAIT_L(n) asm volatile("s_waitcnt lgkmcnt(" #n ")" ::: "memory")
#define PG8_BAR __builtin_amdgcn_s_barrier()
#define PG8_SCHED __builtin_amdgcn_sched_barrier(0)
    Unit cur, nxt; int ui = 0;
    if (!S.next(0, cur)) return;
    f32x4 acc[2][2][4][2];
#pragma unroll
    for (int a = 0; a < 2; ++a)
#pragma unroll
        for (int b = 0; b < 2; ++b)
#pragma unroll
            for (int m = 0; m < 4; ++m)
#pragma unroll
                for (int n = 0; n < 2; ++n) acc[a][b][m][n] = (f32x4){0.f, 0.f, 0.f, 0.f};
    bf16x8 At[4][2], B0[2][2], B1[2][2];
    const char* cA = (const char*)g.A + (size_t)cur.pm * tstep; const char* cB = (const char*)g.Bt + (size_t)cur.pn * tstep;
    S.a_ready(cur);
    if constexpr (SP2) {
        PG8_STAGE(PG8_SB(0, 0), cB, voffB); PG8_STAGE(PG8_SB(0, 1), cB + hstep, voffB); PG8_STAGE(PG8_SA(0, 0), cA, voffA); PG8_STAGE(PG8_SA(0, 1), cA + hstep, voffA);
        if (wr == 1) PG8_BAR;
        PG8_WAIT_V(2); PG8_BAR;
        PG8_STAGE(PG8_SB(1, 0), cB + kstep, voffB); PG8_STAGE(PG8_SA(1, 0), cA + kstep, voffA); PG8_STAGE(PG8_SB(1, 1), cB + hstep + kstep, voffB);
        PG8_WAIT_V(6); PG8_BAR;
    } else {
        PG8_STAGE(PG8_SB(0, 0), cB, voffB); PG8_STAGE(PG8_SA(0, 0), cA, voffA); PG8_STAGE(PG8_SB(0, 1), cB + hstep, voffB); PG8_STAGE(PG8_SA(0, 1), cA + hstep, voffA);
        if (wr == 1) PG8_BAR;
        PG8_WAIT_V(4); PG8_BAR;
        PG8_STAGE(PG8_SB(1, 0), cB + kstep, voffB); PG8_STAGE(PG8_SA(1, 0), cA + kstep, voffA); PG8_STAGE(PG8_SB(1, 1), cB + hstep + kstep, voffB);
        PG8_WAIT_V(6); PG8_BAR;
    }
    for (;;) {
        const bool has_next = S.next(ui + 1, nxt);
        const char* nA = has_next ? (const char*)g.A + (size_t)nxt.pm * tstep : cA; const char* nB = has_next ? (const char*)g.Bt + (size_t)nxt.pn * tstep : cB;
        for (int t = 0; t < nt; t += 2) {
            const bool last = (t == nt - 2);
            const char* a1 = cA + (size_t)(t + 1) * kstep;
            const char* a2 = last ? nA : cA + (size_t)(t + 2) * kstep; const char* b2 = last ? nB : cB + (size_t)(t + 2) * kstep;
            const char* a3 = a2 + kstep; const char* b3 = b2 + kstep;
            if (last && has_next) S.a_ready(nxt);
            if constexpr (SP2) {
            PG8_LDB(B0, 0, 0); PG8_LDB(B1, 0, 1); PG8_SCHED; PG8_LDA(At, 0, 0); PG8_STAGE(PG8_SA(1, 1), a1 + hstep, voffA);
            PG8_WAIT_V(8); PG8_WAIT_L(0); PG8_BAR; PG8_MMA(0, 0, At, B0); PG8_MMA(0, 1, At, B1); PG8_BAR; PG8_SCHED;
            PG8_LDA(At, 0, 1); PG8_STAGE(PG8_SB(0, 0), b2, voffB); PG8_STAGE(PG8_SB(0, 1), b2 + hstep, voffB); PG8_STAGE(PG8_SA(0, 0), a2, voffA);
            PG8_WAIT_V(8); PG8_WAIT_L(0); PG8_BAR; PG8_MMA(1, 0, At, B0); PG8_MMA(1, 1, At, B1); PG8_BAR; PG8_SCHED;
            PG8_LDB(B0, 1, 0); PG8_LDB(B1, 1, 1); PG8_SCHED; PG8_LDA(At, 1, 0); PG8_STAGE(PG8_SA(0, 1), a2 + hstep, voffA);
            PG8_WAIT_V(8); PG8_WAIT_L(0); PG8_BAR; PG8_MMA(0, 0, At, B0); PG8_MMA(0, 1, At, B1); PG8_BAR; PG8_SCHED;
            PG8_LDA(At, 1, 1); PG8_STAGE(PG8_SB(1, 0), b3, voffB); PG8_STAGE(PG8_SB(1, 1), b3 + hstep, voffB); PG8_STAGE(PG8_SA(1, 0), a3, voffA);
            PG8_WAIT_V(8); PG8_WAIT_L(0); PG8_BAR; PG8_MMA(1, 0, At, B0); PG8_MMA(1, 1, At, B1); PG8_BAR; PG8_SCHED;
            } else {
            PG8_LDB(B0, 0, 0); PG8_SCHED; PG8_LDA(At, 0, 0); PG8_STAGE(PG8_SA(1, 1), a1 + hstep, voffA);
            PG8_WAIT_L(8); PG8_BAR; PG8_WAIT_L(0); PG8_MMA(0, 0, At, B0); PG8_BAR; PG8_SCHED;
            PG8_LDB(B1, 0, 1); PG8_STAGE(PG8_SB(0, 0), b2, voffB);
            PG8_BAR; PG8_WAIT_L(0); PG8_MMA(0, 1, At, B1); PG8_BAR;
            PG8_LDA(At, 0, 1); PG8_STAGE(PG8_SA(0, 0), a2, voffA);
            PG8_BAR; PG8_WAIT_L(0); PG8_MMA(1, 0, At, B0); PG8_BAR; PG8_SCHED;
            PG8_STAGE(PG8_SB(0, 1), b2 + hstep, voffB);
            PG8_WAIT_V(6); PG8_BAR; PG8_MMA(1, 1, At, B1); PG8_BAR;
            PG8_LDB(B0, 1, 0); PG8_SCHED; PG8_LDA(At, 1, 0); PG8_STAGE(PG8_SA(0, 1), a2 + hstep, voffA);
            PG8_WAIT_L(8); PG8_BAR; PG8_WAIT_L(0); PG8_MMA(0, 0, At, B0); PG8_BAR; PG8_SCHED;
            PG8_LDB(B1, 1, 1); PG8_STAGE(PG8_SB(1, 0), b3, voffB);
            PG8_BAR; PG8_WAIT_L(0); PG8_MMA(0, 1, At, B1); PG8_BAR;
            PG8_LDA(At, 1, 1); PG8_STAGE(PG8_SA(1, 0), a3, voffA);
            PG8_BAR; PG8_WAIT_L(0); PG8_MMA(1, 0, At, B0); PG8_BAR; PG8_SCHED;
            PG8_STAGE(PG8_SB(1, 1), b3 + hstep, voffB);
            PG8_WAIT_V(6); PG8_BAR; PG8_MMA(1, 1, At, B1); PG8_BAR;
            }
        }
        if constexpr (ALIGN_EPI) { if (wr == 0) PG8_BAR; }
        if constexpr (!Epi::AFTER_DRAIN) { E(acc, cur, wr, wc, fr, fq); S.done(cur); }
        if (!has_next) break;
#pragma unroll
        for (int a = 0; a < 2; ++a)
#pragma unroll
            for (int b = 0; b < 2; ++b)
#pragma unroll
                for (int m = 0; m < 4; ++m)
#pragma unroll
                    for (int n = 0; n < 2; ++n) acc[a][b][m][n] = (f32x4){0.f, 0.f, 0.f, 0.f};
        cur = nxt; cA = nA; cB = nB; ++ui;
        if constexpr (ALIGN_EPI) { if (wr == 1) PG8_BAR; }
    }
    PG8_WAIT_V(0);
    if constexpr (!ALIGN_EPI) { if (wr == 0) PG8_BAR; }
    PG8_BAR;
    if constexpr (Epi::AFTER_DRAIN) { E.fused(acc, cur, wr, wc, fr, fq, lds, wid, lane); S.done(cur); }
#undef PG8_SA
#undef PG8_SB
#undef PG8_STAGE
#undef PG8_LDA
#undef PG8_LDB
#undef PG8_MMA
#undef PG8_WAIT_V
#undef PG8_WAIT_L
#undef PG8_BAR
#undef PG8_SCHED
}
}

#define LAS __attribute__((address_space(3)))
#define GAS __attribute__((address_space(1)))
typedef unsigned short bf16_t;
typedef short bf16x8 __attribute__((ext_vector_type(8)));
typedef short s16x4 __attribute__((ext_vector_type(4)));
typedef float f32x4 __attribute__((ext_vector_type(4)));
typedef unsigned u32x4 __attribute__((ext_vector_type(4)));
typedef unsigned u32x2 __attribute__((ext_vector_type(2)));
constexpr int M = 16384, D = 1024, SEQ = 2048, DEPTH = 4, NIN = 5120, DFF = 2816, NUP = 5632;
constexpr size_t MiB = 1u << 20;
constexpr size_t WS_SS = 302 * MiB;
constexpr size_t WS_ROPE = 1 * MiB;
constexpr size_t WS_W = 2 * MiB, W_SET = 30 * MiB;
constexpr size_t W_IN = 0, W_PA = 10 * MiB, W_PB = W_PA + MiB / 2, W_OUT = 11 * MiB, W_UP = 13 * MiB, W_DN = 24 * MiB;
constexpr size_t WS_XB = 62 * MiB;
constexpr size_t WS_PROJ = 94 * MiB;
constexpr size_t WS_ATTA = 254 * MiB, WS_ATTB = 262 * MiB;
constexpr size_t WS_MIX = 270 * MiB;
constexpr size_t WS_G = 94 * MiB;
constexpr size_t WS_EXA = 182 * MiB, WS_EXB = 190 * MiB;
constexpr size_t WS_END = 311 * MiB;
constexpr int LDS_BYTES = 147456;
constexpr int NWAVES = 8;

struct Args { const float* x; const int* pos; const float* norm_mix; const float* w_in; const float* b_gate; const float* w_proj_a; const float* w_proj_b; const float* w_out;
              const float* norm_ffn; const float* w_up; const float* conv_w; const float* conv_b; const float* w_down; const float* norm_final; float* out; unsigned char* ws; float inv_freq[8]; };

__device__ __forceinline__ float wave_sum(float v) {
#pragma unroll
    for (int o = 1; o < 64; o <<= 1) v += __shfl_xor(v, o);
    return v;
}
__device__ __forceinline__ unsigned pk2(float lo, float hi) { return pg8::cvt_pk_bf16(lo, hi); }
__device__ __forceinline__ float bflo(unsigned w) { return __uint_as_float(w << 16); }
__device__ __forceinline__ float bfhi(unsigned w) { return __uint_as_float(w & 0xffff0000u); }

__device__ __forceinline__ void transpose_item(const float* W, int K, int N, const float* gain, bf16_t* WT, int item, int lane, bool perm_up = false) {
    const int nblk = N / 64, kb = item / nblk, nb = item % nblk, k0 = 64 * kb, n0 = 64 * nb;
    int n0d = n0;
    if (perm_up) { const int c = n0 < DFF ? n0 : n0 - DFF; n0d = (c >> 7) * 256 + (c & 127) + (n0 < DFF ? 0 : 128); }
    const float* src = W + (size_t)k0 * N + n0 + lane;
    float v[64];
#pragma unroll
    for (int kk = 0; kk < 64; ++kk) v[kk] = src[(size_t)kk * N];
    if (gain) {
#pragma unroll
        for (int k4 = 0; k4 < 16; ++k4) { const f32x4 gq = *(const f32x4*)(gain + k0 + 4 * k4);
#pragma unroll
            for (int e = 0; e < 4; ++e) v[4 * k4 + e] *= gq[e]; }
    }
    bf16_t* dst = WT + (size_t)(n0d + lane) * K + k0;
#pragma unroll
    for (int c = 0; c < 8; ++c) { u32x4 o; o.x = pk2(v[8 * c], v[8 * c + 1]); o.y = pk2(v[8 * c + 2], v[8 * c + 3]); o.z = pk2(v[8 * c + 4], v[8 * c + 5]); o.w = pk2(v[8 * c + 6], v[8 * c + 7]);
        *(u32x4*)(dst + 8 * c) = o; }
}
__device__ __forceinline__ void convert_layer(const Args& a, int l, LAS unsigned char* lds, int gw, int ngw, int wave, int lane) {
    unsigned char* set = a.ws + WS_W + (size_t)(l & 1) * W_SET;
    constexpr int I_IN = (D / 64) * (NIN / 64), I_P = (256 / 64) * (D / 64), I_O = (D / 64) * (D / 64), I_UP = (D / 64) * (NUP / 64), I_DN = (DFF / 64) * (D / 64);
    constexpr int NITEMS = I_IN + 2 * I_P + I_O + I_UP + I_DN;
    for (int it = gw; it < NITEMS; it += ngw) {
        int r = it;
        if (r < I_IN) { transpose_item(a.w_in + (size_t)l * D * NIN, D, NIN, a.norm_mix + l * D, (bf16_t*)(set + W_IN), r, lane); continue; } r -= I_IN;
        if (r < I_P) { transpose_item(a.w_proj_a + (size_t)l * 256 * D, 256, D, nullptr, (bf16_t*)(set + W_PA), r, lane); continue; } r -= I_P;
        if (r < I_P) { transpose_item(a.w_proj_b + (size_t)l * 256 * D, 256, D, nullptr, (bf16_t*)(set + W_PB), r, lane); continue; } r -= I_P;
        if (r < I_O) { transpose_item(a.w_out + (size_t)l * D * D, D, D, nullptr, (bf16_t*)(set + W_OUT), r, lane); continue; } r -= I_O;
        if (r < I_UP) { transpose_item(a.w_up + (size_t)l * D * NUP, D, NUP, a.norm_ffn + l * D, (bf16_t*)(set + W_UP), r, lane, true); continue; } r -= I_UP;
        transpose_item(a.w_down + (size_t)l * DFF * D, DFF, D, nullptr, (bf16_t*)(set + W_DN), r, lane);
    }
}

constexpr int VROW = 144;
constexpr float LOG2E = 1.4426950408889634f;
struct TileRegs { bf16x8 k0, k1; u32x4 v0, v1; };
__device__ __forceinline__ void load_tile(TileRegs& t, const bf16_t* kp, const bf16_t* vp) {
    t.k0 = *(const bf16x8*)kp; t.k1 = *(const bf16x8*)(kp + 32); t.v0 = *(const u32x4*)vp; t.v1 = *(const u32x4*)(vp + 8);
}
typedef short v4i16_t __attribute__((ext_vector_type(4)));
__device__ __forceinline__ s16x4 vtr(const LAS unsigned char* p) { return __builtin_bit_cast(s16x4, __builtin_amdgcn_ds_read_tr16_b64_v4i16((LAS v4i16_t*)p)); }
__device__ __forceinline__ void pv_tile(f32x4 (&O)[4], LAS unsigned char* vlds, const u32x4 vr0, const u32x4 vr1, const s16x4 pf, int lane) {
    LAS unsigned char* wp = vlds + (lane >> 2) * VROW + (lane & 3) * 32;
    *(LAS u32x4*)wp = vr0; *(LAS u32x4*)(wp + 16) = vr1;
    asm volatile("" ::: "memory");
    const int fr = lane & 15, fq = lane >> 4;
    const LAS unsigned char* rp = vlds + (4 * fq + (fr >> 2)) * VROW + (fr & 3) * 8;
#pragma unroll
    for (int dt = 0; dt < 4; ++dt) { const s16x4 vt = vtr(rp + dt * 32); O[dt] = __builtin_amdgcn_mfma_f32_16x16x16bf16_1k(vt, pf, O[dt], 0, 0, 0); }
    asm volatile("" ::: "memory");
}
__device__ __forceinline__ s16x4 pack_p(const float (&p)[4]) { u32x2 w; w.x = pk2(p[0], p[1]); w.y = pk2(p[2], p[3]); return __builtin_bit_cast(s16x4, w); }
__device__ __forceinline__ int clampi(int v, int lo, int hi) { return v < lo ? lo : (v > hi ? hi : v); }

constexpr int NH = 2;
constexpr int NQ = 2;
constexpr int RSTEP = 16 / NQ, RSH = (NQ == 4 ? 2 : 3);
struct DilGeo { const bf16_t* kcol; const bf16_t* vcol; int rg, dl, ulo, NT; };
__device__ __forceinline__ void dil_load(TileRegs& dst, const DilGeo& G_, int kt, int lane) {
    const int fr = lane & 15;
    const int tk = clampi(G_.rg + G_.dl * (G_.ulo + 16 * kt + fr), 0, SEQ - 1), tv = clampi(G_.rg + G_.dl * (G_.ulo + 16 * kt + (lane >> 2)), 0, SEQ - 1);
    load_tile(dst, G_.kcol + (size_t)tk * NIN, G_.vcol + (size_t)tv * NIN);
}
__device__ __forceinline__ f32x4 qk_mfma(const bf16x8 k0, const bf16x8 q0, const bf16x8 k1, const bf16x8 q1) {
    f32x4 s;
    asm volatile("s_nop 1\n\tv_mfma_f32_16x16x32_bf16 %0, %1, %2, 0\n\tv_mfma_f32_16x16x32_bf16 %0, %3, %4, %0\n\ts_nop 7\n\ts_nop 7" : "=&v"(s) : "v"(k0), "v"(q0), "v"(k1), "v"(q1));
    return s;
}
__device__ __forceinline__ void pv_mfma(f32x4 (&O)[4], const s16x4 (&vt)[4], const s16x4 pf) {
    asm volatile("s_nop 1\n\tv_mfma_f32_16x16x16_bf16 %0, %4, %8, %0\n\tv_mfma_f32_16x16x16_bf16 %1, %5, %8, %1\n\tv_mfma_f32_16x16x16_bf16 %2, %6, %8, %2\n\tv_mfma_f32_16x16x16_bf16 %3, %7, %8, %3\n\ts_nop 7\n\ts_nop 7"
                 : "+v"(O[0]), "+v"(O[1]), "+v"(O[2]), "+v"(O[3]) : "v"(vt[0]), "v"(vt[1]), "v"(vt[2]), "v"(vt[3]), "v"(pf));
}
__device__ __forceinline__ void stage_v(s16x4 (&vt)[4], LAS unsigned char* vlds, const u32x4 vr0, const u32x4 vr1, int lane) {
    LAS unsigned char* wp = vlds + (lane >> 2) * VROW + (lane & 3) * 32;
    *(LAS u32x4*)wp = vr0; *(LAS u32x4*)(wp + 16) = vr1;
    asm volatile("" ::: "memory");
    const int fr = lane & 15, fq = lane >> 4;
    const LAS unsigned char* rp = vlds + (4 * fq + (fr >> 2)) * VROW + (fr & 3) * 8;
#pragma unroll
    for (int dt = 0; dt < 4; ++dt) vt[dt] = vtr(rp + dt * 32);
    asm volatile("" ::: "memory");
}
__device__ __forceinline__ void dil_pair(const TileRegs& cur, const s16x4 (&vt)[4], const bf16x8 q0, const bf16x8 q1, int ub, int uq, float& m_run, float& l_run, f32x4 (&O)[4]) {
    const f32x4 s = qk_mfma(cur.k0, q0, cur.k1, q1);
    const int d0 = ub - uq + 128;
    float sm[4];
#pragma unroll
    for (int v = 0; v < 4; ++v) { const bool ok = ((unsigned)(d0 + v) <= 128u) & ((ub + v) >= 0); sm[v] = ok ? s[v] : -INFINITY; }
    float tr = fmaxf(fmaxf(sm[0], sm[1]), fmaxf(sm[2], sm[3]));
    tr = fmaxf(tr, pg8::xor16f(tr)); tr = pg8::max32f(tr);
    const float tmax = tr * (0.125f * LOG2E);
    if (__builtin_amdgcn_ballot_w64(tmax > m_run + 8.0f) != 0ull) {
        asm volatile("" ::: );
        const float m_new = (tmax > m_run + 8.0f) ? tmax : m_run;
        const float alpha = __builtin_amdgcn_exp2f(m_run - m_new);
        m_run = m_new; l_run *= alpha;
#pragma unroll
        for (int dt = 0; dt < 4; ++dt) O[dt] = O[dt] * alpha;
    }
    float p[4];
#pragma unroll
    for (int v = 0; v < 4; ++v) p[v] = __builtin_amdgcn_exp2f(fmaf(sm[v], 0.125f * LOG2E, -m_run));
    l_run += (p[0] + p[1]) + (p[2] + p[3]);
    pv_mfma(O, vt, pack_p(p));
}
__device__ __forceinline__ void dil_tile_shared(const TileRegs& cur, const DilGeo& G_, int kt, const bf16x8 (&q0)[NQ], const bf16x8 (&q1)[NQ], const int (&uq)[NQ],
                                                float (&m_run)[NQ], float (&l_run)[NQ], f32x4 (&O)[NQ][4], LAS unsigned char* vlds, int lane) {
    s16x4 vt[4]; stage_v(vt, vlds, cur.v0, cur.v1, lane);
    const int ub = G_.ulo + 16 * kt + 4 * (lane >> 4);
#pragma unroll
    for (int c = 0; c < NQ; ++c) { dil_pair(cur, vt, q0[c], q1[c], ub, uq[c], m_run[c], l_run[c], O[c]); if (c & 1) __builtin_amdgcn_sched_barrier(0); }
}
__device__ __forceinline__ void dil_tile_one(const TileRegs& cur, const DilGeo& G_, int kt, const bf16x8 q0, const bf16x8 q1, int uq, float& m_run, float& l_run, f32x4 (&O)[4], LAS unsigned char* vlds, int lane) {
    s16x4 vt[4]; stage_v(vt, vlds, cur.v0, cur.v1, lane);
    dil_pair(cur, vt, q0, q1, G_.ulo + 16 * kt + 4 * (lane >> 4), uq, m_run, l_run, O);
}
__device__ __forceinline__ void dil_unit(const bf16_t* PROJ, bf16_t* ATTA, LAS unsigned char* vlds, int unit, int lane) {
    const int fr = lane & 15, fq = lane >> 4;
    const int iblk = unit & 7, r4 = (unit >> 3) & (RSTEP - 1), h = (unit >> (3 + RSH)) & 3, b = unit >> (5 + RSH);
    const bf16_t* base = PROJ + (size_t)b * SEQ * NIN;
    const int i0 = iblk * 16;
    float m_run[NQ], l_run[NQ];
    f32x4 O[NQ][4];
    float z0_ = 0.f; asm volatile("" : "+v"(z0_));
#pragma unroll
    for (int c = 0; c < NQ; ++c) { m_run[c] = -1e30f + z0_; l_run[c] = z0_;
#pragma unroll
        for (int dt = 0; dt < 4; ++dt) O[c][dt] = (f32x4){z0_, z0_, z0_, z0_}; }
#pragma unroll 1
    for (int g = 0; g < 2; ++g) {
        const int sh = 2 * g, dl = 1 << sh, sq = 16 >> sh;
        const int rg = r4 & (dl - 1);
        const int colq = g * 256 + h * 64;
        bf16x8 q0[NQ], q1[NQ]; int uq[NQ];
#pragma unroll
        for (int c = 0; c < NQ; ++c) { const int rc = r4 + RSTEP * c, tq = rc + 16 * (i0 + fr);
            const bf16_t* qp = base + (size_t)tq * NIN + colq + 8 * fq; q0[c] = *(const bf16x8*)qp; q1[c] = *(const bf16x8*)(qp + 32);
            uq[c] = ((rc - rg) >> sh) + sq * i0 + sq * fr; }
        DilGeo G_; G_.kcol = base + 768 + colq + 8 * fq; G_.vcol = base + 1536 + colq + 16 * (lane & 3); G_.rg = rg; G_.dl = dl;
        G_.ulo = ((r4 - rg) >> sh) + sq * i0 - 128;
        G_.NT = (g == 0) ? 24 : 12;
        const int NT = G_.NT;
        int kt = G_.ulo >= 0 ? 0 : ((-G_.ulo) >> 4);
        TileRegs b0, b1, b2;
        dil_load(b0, G_, kt, lane);
        dil_load(b1, G_, kt + 1 < NT ? kt + 1 : NT - 1, lane);
#pragma unroll 1
        for (; kt < NT; kt += 3) {
            dil_load(b2, G_, kt + 2 < NT ? kt + 2 : NT - 1, lane);
            dil_tile_shared(b0, G_, kt, q0, q1, uq, m_run, l_run, O, vlds, lane);
            dil_load(b0, G_, kt + 3 < NT ? kt + 3 : NT - 1, lane);
            dil_tile_shared(b1, G_, kt + 1, q0, q1, uq, m_run, l_run, O, vlds, lane);
            dil_load(b1, G_, kt + 4 < NT ? kt + 4 : NT - 1, lane);
            dil_tile_shared(b2, G_, kt + 2, q0, q1, uq, m_run, l_run, O, vlds, lane);
        }
    }
#pragma unroll
    for (int c = 0; c < NQ; ++c) {
        const int rc = r4 + RSTEP * c, tq = rc + 16 * (i0 + fr);
        const int colq = 2 * 256 + h * 64;
        const bf16_t* qp = base + (size_t)tq * NIN + colq + 8 * fq;
        const bf16x8 q0 = *(const bf16x8*)qp, q1 = *(const bf16x8*)(qp + 32);
        const int uq = i0 + fr;
        DilGeo G_; G_.kcol = base + 768 + colq + 8 * fq; G_.vcol = base + 1536 + colq + 16 * (lane & 3); G_.rg = rc; G_.dl = 16; G_.ulo = i0 - 128; G_.NT = 9;
        int kt = G_.ulo >= 0 ? 0 : ((-G_.ulo) >> 4);
        TileRegs b0, b1, b2;
        dil_load(b0, G_, kt, lane);
        dil_load(b1, G_, kt + 1 < 9 ? kt + 1 : 8, lane);
#pragma unroll 1
        for (; kt < 9; kt += 3) {
            dil_load(b2, G_, kt + 2 < 9 ? kt + 2 : 8, lane);
            dil_tile_one(b0, G_, kt, q0, q1, uq, m_run[c], l_run[c], O[c], vlds, lane);
            dil_load(b0, G_, kt + 3 < 9 ? kt + 3 : 8, lane);
            dil_tile_one(b1, G_, kt + 1, q0, q1, uq, m_run[c], l_run[c], O[c], vlds, lane);
            dil_load(b1, G_, kt + 4 < 9 ? kt + 4 : 8, lane);
            dil_tile_one(b2, G_, kt + 2, q0, q1, uq, m_run[c], l_run[c], O[c], vlds, lane);
        }
    }
#pragma unroll
    for (int c = 0; c < NQ; ++c) {
        const int tq = r4 + RSTEP * c + 16 * (i0 + fr);
        float l = l_run[c]; l += pg8::xor16f(l); l += pg8::xor32f(l);
        const float inv = 1.0f / l;
        bf16_t* op = ATTA + (size_t)(b * SEQ + tq) * 256 + h * 64 + 4 * fq;
#pragma unroll
        for (int dt = 0; dt < 4; ++dt) { u32x2 w; w.x = pk2(O[c][dt][0] * inv, O[c][dt][1] * inv); w.y = pk2(O[c][dt][2] * inv, O[c][dt][3] * inv); *(u32x2*)(op + 16 * dt) = w; }
    }
}

__device__ __forceinline__ void unpack8(const u32x4 w, float (&f)[8]);
constexpr int NAT_O = 0, NAT_LSE = 98304, NAT_V = 102400;
__device__ __forceinline__ void nat_store(LAS unsigned char* lds, int g, int tl, f32x4 (&O)[4], float m_run, float l_run, int lane) {
    const int fq = lane >> 4;

    float l = l_run; l += pg8::xor16f(l); l += pg8::xor32f(l);
    const float inv = 1.0f / l;
    LAS unsigned char* op = lds + NAT_O + (g * 256 + tl) * 128 + 8 * fq;
#pragma unroll
    for (int dt = 0; dt < 4; ++dt) { u32x2 w; w.x = pk2(O[dt][0] * inv, O[dt][1] * inv); w.y = pk2(O[dt][2] * inv, O[dt][3] * inv); *(LAS u32x2*)(op + 32 * dt) = w; }
    if (fq == 0) *(LAS float*)(lds + NAT_LSE + (g * 256 + tl) * 4) = m_run + __log2f(l);
}
__device__ __forceinline__ void nat_two(const bf16_t* base, int h, int g, int rg, int dl, int u0, int ublk0, LAS unsigned char* lds, LAS unsigned char* vlds, int lane) {
    const int fr = lane & 15, fq = lane >> 4;
    const int colq = g * 256 + h * 64;
    float z0_ = 0.f; asm volatile("" : "+v"(z0_));
    float m_run[2], l_run[2]; f32x4 O[2][4]; bf16x8 q0[2], q1[2]; int uq[2];
#pragma unroll
    for (int c = 0; c < 2; ++c) { m_run[c] = -1e30f + z0_; l_run[c] = z0_; uq[c] = u0 + 16 * c + fr;
        const bf16_t* qp = base + (size_t)(rg + dl * uq[c]) * NIN + colq + 8 * fq; q0[c] = *(const bf16x8*)qp; q1[c] = *(const bf16x8*)(qp + 32);
#pragma unroll
        for (int dt = 0; dt < 4; ++dt) O[c][dt] = (f32x4){z0_, z0_, z0_, z0_}; }
    DilGeo G_; G_.kcol = base + 768 + colq + 8 * fq; G_.vcol = base + 1536 + colq + 16 * (lane & 3); G_.rg = rg; G_.dl = dl; G_.ulo = u0 - 128; G_.NT = 10;
    int kt = G_.ulo >= 0 ? 0 : ((-G_.ulo) >> 4);
    TileRegs b0, b1, b2;
    dil_load(b0, G_, kt, lane);
    dil_load(b1, G_, kt + 1 < 10 ? kt + 1 : 9, lane);
#define NAT_STEP(buf, t) do { if ((t) < 10) { s16x4 vt_[4]; stage_v(vt_, vlds, buf.v0, buf.v1, lane); const int ub_ = G_.ulo + 16 * (t) + 4 * fq; \
        if ((t) <= 8) dil_pair(buf, vt_, q0[0], q1[0], ub_, uq[0], m_run[0], l_run[0], O[0]); \
        if ((t) >= 1) dil_pair(buf, vt_, q0[1], q1[1], ub_, uq[1], m_run[1], l_run[1], O[1]); } } while (0)
#pragma unroll 1
    for (; kt < 10; kt += 3) {
        dil_load(b2, G_, kt + 2 < 10 ? kt + 2 : 9, lane);
        NAT_STEP(b0, kt);
        dil_load(b0, G_, kt + 3 < 10 ? kt + 3 : 9, lane);
        NAT_STEP(b1, kt + 1);
        dil_load(b1, G_, kt + 4 < 10 ? kt + 4 : 9, lane);
        NAT_STEP(b2, kt + 2);
    }
#undef NAT_STEP
#pragma unroll
    for (int c = 0; c < 2; ++c) nat_store(lds, g, rg + dl * (u0 + 16 * c + fr - ublk0), O[c], m_run[c], l_run[c], lane);
}
__device__ __forceinline__ void nat_one(const bf16_t* base, int h, int g, int rg, int dl, int u0, int ublk0, LAS unsigned char* lds, LAS unsigned char* vlds, int lane) {
    const int fr = lane & 15, fq = lane >> 4;
    const int colq = g * 256 + h * 64;
    float z0_ = 0.f; asm volatile("" : "+v"(z0_));
    float m_run = -1e30f + z0_, l_run = z0_; f32x4 O[4];
#pragma unroll
    for (int dt = 0; dt < 4; ++dt) O[dt] = (f32x4){z0_, z0_, z0_, z0_};
    const int uq = u0 + fr;
    const bf16_t* qp = base + (size_t)(rg + dl * uq) * NIN + colq + 8 * fq;
    const bf16x8 q0 = *(const bf16x8*)qp, q1 = *(const bf16x8*)(qp + 32);
    DilGeo G_; G_.kcol = base + 768 + colq + 8 * fq; G_.vcol = base + 1536 + colq + 16 * (lane & 3); G_.rg = rg; G_.dl = dl; G_.ulo = u0 - 128; G_.NT = 9;
    int kt = G_.ulo >= 0 ? 0 : ((-G_.ulo) >> 4);
    TileRegs b0, b1, b2;
    dil_load(b0, G_, kt, lane);
    dil_load(b1, G_, kt + 1 < 9 ? kt + 1 : 8, lane);
#pragma unroll 1
    for (; kt < 9; kt += 3) {
        dil_load(b2, G_, kt + 2 < 9 ? kt + 2 : 8, lane);
        dil_tile_one(b0, G_, kt, q0, q1, uq, m_run, l_run, O, vlds, lane);
        dil_load(b0, G_, kt + 3 < 9 ? kt + 3 : 8, lane);
        dil_tile_one(b1, G_, kt + 1, q0, q1, uq, m_run, l_run, O, vlds, lane);
        dil_load(b1, G_, kt + 4 < 9 ? kt + 4 : 8, lane);
        dil_tile_one(b2, G_, kt + 2, q0, q1, uq, m_run, l_run, O, vlds, lane);
    }
    nat_store(lds, g, rg + dl * (uq - ublk0), O, m_run, l_run, lane);
}
__device__ __forceinline__ void dil_block(const bf16_t* PROJ, bf16_t* ATTA, LAS unsigned char* lds, int unit, int wave, int lane) {
    const int blk = unit & 7, h = (unit >> 3) & 3, b = unit >> 5;
    const bf16_t* base = PROJ + (size_t)b * SEQ * NIN;
    LAS unsigned char* vlds = lds + NAT_V + wave * 2304;
    const int t0 = 256 * blk;
    nat_two(base, h, 0, 0, 1, t0 + 32 * wave, t0, lds, vlds, lane);
    nat_two(base, h, 1, wave >> 1, 4, (t0 >> 2) + 32 * (wave & 1), t0 >> 2, lds, vlds, lane);
    nat_one(base, h, 2, 2 * wave, 16, t0 >> 4, t0 >> 4, lds, vlds, lane);
    nat_one(base, h, 2, 2 * wave + 1, 16, t0 >> 4, t0 >> 4, lds, vlds, lane);
    asm volatile("s_waitcnt lgkmcnt(0)" ::: "memory"); __syncthreads();
    for (int it = wave * 64 + lane; it < 256 * 8; it += NWAVES * 64) {
        const int tl = it >> 3, c8 = it & 7;
        const float e0 = *(const LAS float*)(lds + NAT_LSE + (0 * 256 + tl) * 4), e1 = *(const LAS float*)(lds + NAT_LSE + (1 * 256 + tl) * 4), e2 = *(const LAS float*)(lds + NAT_LSE + (2 * 256 + tl) * 4);
        const float mx = fmaxf(e0, fmaxf(e1, e2));
        float w0 = __builtin_amdgcn_exp2f(e0 - mx), w1 = __builtin_amdgcn_exp2f(e1 - mx), w2 = __builtin_amdgcn_exp2f(e2 - mx);
        const float inv = 1.0f / (w0 + w1 + w2); w0 *= inv; w1 *= inv; w2 *= inv;
        const u32x4 a = *(const LAS u32x4*)(lds + NAT_O + (0 * 256 + tl) * 128 + 16 * c8), bq = *(const LAS u32x4*)(lds + NAT_O + (1 * 256 + tl) * 128 + 16 * c8),
                    cq = *(const LAS u32x4*)(lds + NAT_O + (2 * 256 + tl) * 128 + 16 * c8);
        float fa[8], fb[8], fc[8], o[8];
        unpack8(a, fa); unpack8(bq, fb); unpack8(cq, fc);
#pragma unroll
        for (int e = 0; e < 8; ++e) o[e] = w0 * fa[e] + w1 * fb[e] + w2 * fc[e];
        u32x4 w; w.x = pk2(o[0], o[1]); w.y = pk2(o[2], o[3]); w.z = pk2(o[4], o[5]); w.w = pk2(o[6], o[7]);
        *(u32x4*)(ATTA + (size_t)(b * SEQ + t0 + tl) * 256 + h * 64 + 8 * c8) = w;
    }
    asm volatile("s_waitcnt lgkmcnt(0)" ::: "memory"); __syncthreads();
}

__device__ __forceinline__ void sb_load(TileRegs (&dst)[NH], const bf16_t* kcol, const bf16_t* vcol, int kt) {
#pragma unroll
    for (int hh = 0; hh < NH; ++hh) load_tile(dst[hh], kcol + (size_t)(16 * kt) * NIN + 64 * hh, vcol + (size_t)(16 * kt) * NIN + 64 * hh);
}
__device__ __forceinline__ bool sb_tile(const TileRegs (&cur)[NH], int kt, int tq, const bf16x8 (&q0)[NH], const bf16x8 (&q1)[NH], float (&R)[NH], f32x4 (&O)[NH][4], LAS unsigned char* vlds, int lane) {
    const int fq = lane >> 4;
    const int kb = 16 * kt + 4 * fq;
    bool valid[4];
#pragma unroll
    for (int v = 0; v < 4; ++v) valid[v] = (int)((kb + v) < tq) & (int)(kb >= 0);
    s16x4 pf[NH];
#pragma unroll
    for (int hh = 0; hh < NH; ++hh) {
        f32x4 s = {0.f, 0.f, 0.f, 0.f};
        s = __builtin_amdgcn_mfma_f32_16x16x32_bf16(cur[hh].k0, q0[hh], s, 0, 0, 0);
        s = __builtin_amdgcn_mfma_f32_16x16x32_bf16(cur[hh].k1, q1[hh], s, 0, 0, 0);
        float lk[4], ls[4];
#pragma unroll
        for (int v = 0; v < 4; ++v) { const float z = s[v] * 0.125f;
            const float sp = fmaxf(z, 0.f) + __logf(1.0f + __expf(-fabsf(z)));
            lk[v] = valid[v] ? -sp : 0.f; ls[v] = z - sp; }
        float suf[4]; suf[3] = 0.f; suf[2] = lk[3]; suf[1] = suf[2] + lk[2]; suf[0] = suf[1] + lk[1];
        const float tot = suf[0] + lk[0];
        const float t16 = pg8::xor16f(tot), t32 = pg8::xor32f(tot), t48 = pg8::xor32f(t16);
        const float higher = (((fq ^ 1) > fq) ? t16 : 0.f) + (((fq ^ 2) > fq) ? t32 : 0.f) + (((fq ^ 3) > fq) ? t48 : 0.f);
        const float bv = R[hh] + higher;
        float p[4];
#pragma unroll
        for (int v = 0; v < 4; ++v) p[v] = valid[v] ? __expf(ls[v] + bv + suf[v]) : 0.f;
        R[hh] += (tot + t16) + (t32 + t48);
        pf[hh] = pack_p(p);
    }
#pragma unroll
    for (int hh = 0; hh < NH; ++hh) pv_tile(O[hh], vlds + hh * 4096, cur[hh].v0, cur[hh].v1, pf[hh], lane);
    bool done = true;
#pragma unroll
    for (int hh = 0; hh < NH; ++hh) done = done && (R[hh] < -100.0f);
    return done;
}
__device__ __forceinline__ void sb_unit(const bf16_t* PROJ, bf16_t* ATTB, LAS unsigned char* vlds, int unit, int lane) {
    const int fr = lane & 15, fq = lane >> 4;
    const int qt = unit & 127, hp = (unit >> 7) & 1, b = unit >> 8;
    const bf16_t* base = PROJ + (size_t)b * SEQ * NIN;
    const int tq = 16 * qt + fr;
    const bf16_t* qp = base + (size_t)tq * NIN + 2304 + hp * NH * 64 + 8 * fq;
    bf16x8 q0[NH], q1[NH];
#pragma unroll
    for (int hh = 0; hh < NH; ++hh) { q0[hh] = *(const bf16x8*)(qp + 64 * hh); q1[hh] = *(const bf16x8*)(qp + 64 * hh + 32); }
    const bf16_t* kcol = base + 2560 + hp * NH * 64 + 8 * fq + (size_t)fr * NIN;
    const bf16_t* vcol = base + 2816 + hp * NH * 64 + 16 * (lane & 3) + (size_t)(lane >> 2) * NIN;
    float R[NH];
    f32x4 O[NH][4];
#pragma unroll
    for (int hh = 0; hh < NH; ++hh) { R[hh] = 0.f;
#pragma unroll
        for (int dt = 0; dt < 4; ++dt) O[hh][dt] = (f32x4){0.f, 0.f, 0.f, 0.f}; }
    int kt = qt;
    TileRegs b0[NH], b1[NH], b2[NH];
    sb_load(b0, kcol, vcol, kt);
    sb_load(b1, kcol, vcol, kt >= 1 ? kt - 1 : 0);
#pragma unroll 1
    for (;;) {
        sb_load(b2, kcol, vcol, kt >= 2 ? kt - 2 : 0);
        (void)sb_tile(b0, kt, tq, q0, q1, R, O, vlds, lane);
        sb_load(b0, kcol, vcol, kt >= 3 ? kt - 3 : 0);
        (void)sb_tile(b1, kt - 1, tq, q0, q1, R, O, vlds, lane);
        sb_load(b1, kcol, vcol, kt >= 4 ? kt - 4 : 0);
        const bool done = sb_tile(b2, kt - 2, tq, q0, q1, R, O, vlds, lane);
        kt -= 3;
        if (kt < 0 || __all(done)) break;
    }
#pragma unroll
    for (int hh = 0; hh < NH; ++hh) {
        bf16_t* op = ATTB + (size_t)(b * SEQ + tq) * 256 + (hp * NH + hh) * 64 + 4 * fq;
#pragma unroll
        for (int dt = 0; dt < 4; ++dt) { u32x2 w; w.x = pk2(O[hh][dt][0], O[hh][dt][1]); w.y = pk2(O[hh][dt][2], O[hh][dt][3]); *(u32x2*)(op + 16 * dt) = w; }
    }
}

__device__ __forceinline__ void unpack8(const u32x4 w, float (&f)[8]) { f[0] = bflo(w.x); f[1] = bfhi(w.x); f[2] = bflo(w.y); f[3] = bfhi(w.y); f[4] = bflo(w.z); f[5] = bfhi(w.z); f[6] = bflo(w.w); f[7] = bfhi(w.w); }
__device__ __forceinline__ void fixup_panel(bf16_t* G, const bf16_t* EXA, const bf16_t* EXB, const float* cw, const float* cb, int pm, int tid) {
    constexpr int C8 = DFF / 8;
    if (tid < C8) {
        const int ch = tid * 8;
        float w0[8], w1[8], w2[8], bb[8];
#pragma unroll
        for (int e = 0; e < 8; ++e) { w0[e] = cw[ch + e]; w1[e] = cw[DFF + ch + e]; w2[e] = cw[2 * DFF + ch + e]; bb[e] = cb[ch + e]; }
#pragma unroll
        for (int hp = 0; hp < 2; ++hp) {
            const int cA = 4 * pm + 2 * hp, cB = cA + 1;
            const bool first = (cA & 31) == 0;
            const u32x4 zero = {0u, 0u, 0u, 0u};
            const int cP = first ? cA : cA - 1;
            u32x4 p2 = *(const u32x4*)(EXA + ((size_t)cP * 4 + 2) * DFF + ch), p3 = *(const u32x4*)(EXA + ((size_t)cP * 4 + 3) * DFF + ch);
            const u32x4 a0 = *(const u32x4*)(EXA + ((size_t)cA * 4 + 0) * DFF + ch), a1 = *(const u32x4*)(EXA + ((size_t)cA * 4 + 1) * DFF + ch);
            const u32x4 a2 = *(const u32x4*)(EXA + ((size_t)cA * 4 + 2) * DFF + ch), a3 = *(const u32x4*)(EXA + ((size_t)cA * 4 + 3) * DFF + ch);
            const u32x4 b0 = *(const u32x4*)(EXA + ((size_t)cB * 4 + 0) * DFF + ch), b1 = *(const u32x4*)(EXA + ((size_t)cB * 4 + 1) * DFF + ch);
            const u32x4 ga0 = *(const u32x4*)(EXB + ((size_t)cA * 2 + 0) * DFF + ch), ga1 = *(const u32x4*)(EXB + ((size_t)cA * 2 + 1) * DFF + ch);
            const u32x4 gb0 = *(const u32x4*)(EXB + ((size_t)cB * 2 + 0) * DFF + ch), gb1 = *(const u32x4*)(EXB + ((size_t)cB * 2 + 1) * DFF + ch);
            if (first) { p2 = zero; p3 = zero; }
            const u32x4 cur[4] = {a0, a1, b0, b1}, m1[4] = {p3, a0, a3, b0}, m2[4] = {p2, p3, a2, a3}, gt[4] = {ga0, ga1, gb0, gb1};
#pragma unroll
            for (int k = 0; k < 4; ++k) {
                float x0[8], x1[8], x2[8], gv[8], o[8];
                unpack8(cur[k], x0); unpack8(m1[k], x1); unpack8(m2[k], x2); unpack8(gt[k], gv);
#pragma unroll
                for (int e = 0; e < 8; ++e) { const float y = w0[e] * x2[e] + w1[e] * x1[e] + w2[e] * x0[e] + bb[e]; o[e] = (y * pg8::sigmoidf_(y)) * gv[e]; }
                u32x4 w; w.x = pk2(o[0], o[1]); w.y = pk2(o[2], o[3]); w.z = pk2(o[4], o[5]); w.w = pk2(o[6], o[7]);
                const int c = (k < 2) ? cA : cB;
                *(u32x4*)(G + ((size_t)c * 64 + (k & 1)) * DFF + ch) = w;
            }
        }
    }
}

constexpr size_t WS_BAR = 983040;
#define XB_TMO      128
#define XB_XCNT(j)  (256  + 64 * (j))
#define XB_XSUB(j)  (1280 + 64 * (j))
#define XB_XGEN(j)  (2304 + 64 * (j))
#define XB_TOP      3328
#define XB_TOPGEN   3392
#define XCD_BAR_WORDS 3456
#define XB_SPIN_CAP (1u << 18)
__device__ __forceinline__ unsigned xb_ld(unsigned* p)              { return __hip_atomic_load(p, __ATOMIC_RELAXED, __HIP_MEMORY_SCOPE_AGENT); }
__device__ __forceinline__ unsigned xb_add(unsigned* p, unsigned v) { return __hip_atomic_fetch_add(p, v, __ATOMIC_RELAXED, __HIP_MEMORY_SCOPE_AGENT); }
__device__ __forceinline__ unsigned xb_xcc_id() { return (unsigned)__builtin_amdgcn_s_getreg((3 << 11) | 20) & 0xFu; }
#define XB_SPIN(cond, bar) do { unsigned _sp = 0; while (cond) { __builtin_amdgcn_s_sleep(1); \
    if ((++_sp & 255u) == 0u) { if (xb_ld(&(bar)[XB_TMO])) break; if (_sp > XB_SPIN_CAP) { atomicAdd(&(bar)[XB_TMO], 1u); break; } } } } while (0)
__device__ __forceinline__ void xcd_barrier_complete(unsigned* bar, unsigned x, unsigned& nloc, unsigned& nx) {
    const unsigned G = gridDim.x * gridDim.y * gridDim.z;
    unsigned sum, cnt, mine, sp = 0u;
    for (;;) {
        sum = 0u; cnt = 0u; mine = 0u;
#pragma unroll
        for (unsigned j = 0; j < 16; ++j) { const unsigned c = xb_ld(&bar[XB_XCNT(j)]); sum += c; cnt += (c > 0u) ? 1u : 0u; mine = (j == x) ? c : mine; }
        if (sum == G) break;
        __builtin_amdgcn_s_sleep(1);
        if ((++sp & 255u) == 0u) { if (xb_ld(&bar[XB_TMO])) break; if (sp > XB_SPIN_CAP) { atomicAdd(&bar[XB_TMO], 1u); break; } }
    }
    nloc = mine > 0u ? mine : 1u; nx = cnt > 0u ? cnt : 1u;
}
__device__ __forceinline__ void grid_bar(unsigned* bar, unsigned x, volatile LAS unsigned* st, int wave_s) {
    asm volatile("s_waitcnt vmcnt(0)" ::: "memory");
    __syncthreads();
    if (wave_s == 0) {
      if (pg8::lane_id_asm() == 0) {
        __builtin_amdgcn_s_waitcnt(0);
        unsigned nloc = st[0], nx = st[1];
        if (nloc == 0u) { xcd_barrier_complete(bar, x, nloc, nx); st[0] = nloc; st[1] = nx; }
        const unsigned old = xb_add(&bar[XB_XSUB(x)], 1u);
        const unsigned gen = old / nloc;
        if (old + 1u == (gen + 1u) * nloc) {
            __builtin_amdgcn_fence(__ATOMIC_RELEASE, "agent");
            asm volatile("s_waitcnt vmcnt(0)" ::: "memory");
            const unsigned og = xb_add(&bar[XB_TOP], 1u);
            const unsigned tg = og / nx;
            if (og + 1u == (tg + 1u) * nx) xb_add(&bar[XB_TOPGEN], 1u);
            else XB_SPIN(xb_ld(&bar[XB_TOPGEN]) == tg, bar);
            __builtin_amdgcn_fence(__ATOMIC_ACQUIRE, "agent");
            xb_add(&bar[XB_XGEN(x)], 1u);
            asm volatile("s_waitcnt vmcnt(0)" ::: "memory");
        } else {
            XB_SPIN(xb_ld(&bar[XB_XGEN(x)]) == gen, bar);
            __builtin_amdgcn_fence(__ATOMIC_ACQUIRE, "agent");
            asm volatile("s_waitcnt vmcnt(0)" ::: "memory");
        }
      }
    }
    __syncthreads();
}
__global__ void __launch_bounds__(NWAVES * 64, 2) mk_fwd(Args a) {
    extern __shared__ __attribute__((aligned(16))) unsigned char lds_raw[];
    LAS unsigned char* lds = (LAS unsigned char*)lds_raw;
    const int wave_s = __builtin_amdgcn_readfirstlane((int)threadIdx.x >> 6);
    const int G = gridDim.x, bx = blockIdx.x, ngw = G * NWAVES, nthr = G * NWAVES * 64;
    volatile LAS unsigned* bst = (volatile LAS unsigned*)(lds + 131072 + 256);
    const unsigned xcc = xb_xcc_id();
    if (threadIdx.x == 0) { bst[0] = 0u; bst[1] = 0u; (void)xb_add((unsigned*)(a.ws + WS_BAR) + XB_XCNT(xcc), 1u); }
    {
        cg::grid_group grid = cg::this_grid();
        const int tid = threadIdx.x, lane = tid & 63, gw = bx * NWAVES + wave_s, gtid = bx * (NWAVES * 64) + tid;
        float* SS = (float*)(a.ws + WS_SS); float* ROPE = (float*)(a.ws + WS_ROPE); bf16_t* XB = (bf16_t*)(a.ws + WS_XB);
        convert_layer(a, 0, lds, gw, ngw, wave_s, lane);
        for (int row = gw; row < M; row += ngw) {
            const f32x4* xr = (const f32x4*)(a.x + (size_t)row * D) + lane; float s = 0.f;
            unsigned long long* o8 = (unsigned long long*)(XB + (size_t)row * D) + lane;
#pragma unroll
            for (int j = 0; j < 4; ++j) { const f32x4 v = xr[64 * j]; s += (v[0] * v[0] + v[1] * v[1]) + (v[2] * v[2] + v[3] * v[3]);
                o8[64 * j] = (unsigned long long)pk2(v[0], v[1]) | ((unsigned long long)pk2(v[2], v[3]) << 32); }
            s = wave_sum(s);
            if (lane < 16) SS[(size_t)row * 16 + lane] = (lane == 0) ? s : 0.f;
        }
        for (int i = gtid; i < 8 * M; i += nthr) {
            const int row = i >> 3, e = i & 7;
            const float angf = (float)a.pos[row] * a.inv_freq[e];
            const double x = (double)angf, n = rint(x * 0.15915494309189535), rr = fma(-n, 2.4492935982947064e-16, fma(-n, 6.283185307179586, x)), r2 = rr * rr;
            double sn = 1.0, cs = 1.0;
#pragma unroll
            for (int k = 13; k >= 1; --k) { sn = 1.0 - sn * r2 * (1.0 / (double)((2 * k) * (2 * k + 1))); cs = 1.0 - cs * r2 * (1.0 / (double)((2 * k - 1) * (2 * k))); }
            ROPE[row * 16 + e] = (float)cs; ROPE[row * 16 + 8 + e] = (float)(rr * sn);
        }
        grid.sync();
    }
#ifndef PROBE_BAR
#define PROBE_BAR 1
#endif
#ifndef PROBE_ATT
#define PROBE_ATT 1
#endif
#ifndef PROBE_G1
#define PROBE_G1 1
#endif
#ifndef PROBE_G4
#define PROBE_G4 1
#endif
#ifndef PROBE_DIL
#define PROBE_DIL 1
#endif
#ifndef PROBE_SB
#define PROBE_SB 1
#endif
#ifndef PROBE_CONV
#define PROBE_CONV 1
#endif
#ifndef PROBE_G2
#define PROBE_G2 1
#endif
#define GRID_BAR() do { for (int rb_ = 0; rb_ < PROBE_BAR; ++rb_) { grid_bar((unsigned*)(a.ws + WS_BAR), xcc, bst, wave_s); } } while (0)

#pragma unroll 1
    for (int l = 0; l < DEPTH; ++l) {
        for (int rp_ = 0; rp_ < PROBE_G1; ++rp_) { size_t z_ = 0; asm volatile("" : "+s"(z_)); unsigned char* ws = a.ws + z_; float* outp = a.out + z_; const float* xin = a.x + z_;     unsigned char* set = ws + WS_W + (size_t)(l & 1) * W_SET;
          const float* bg_ = a.b_gate + l * 2 * D + z_;
          pg8::Gemm g{(const bf16_t*)(ws + WS_XB), (const bf16_t*)(set + W_IN), M, NIN, D}; pg8::StaticOrder S; S.init(M, NIN, G, bx);
          pg8::EpiProj E{(bf16_t*)(ws + WS_PROJ), (const float*)(ws + WS_SS) + (size_t)(2 * l) * M * 16, (const float*)(ws + WS_ROPE), bg_, (LAS float*)(lds + 131072 + 1024) + wave_s * 128, -1};
          pg8::gemm_phase<pg8::EpiProj, pg8::StaticOrder, true, true>(lds, g, S, E, wave_s); }
        GRID_BAR();
        for (int rp_ = 0; rp_ < PROBE_ATT; ++rp_) { size_t z_ = 0; asm volatile("" : "+s"(z_)); unsigned char* ws = a.ws + z_; float* outp = a.out + z_; const float* xin = a.x + z_;
          const int vbx_ = (G % 8 == 0) ? (bx % 8) * (G / 8) + bx / 8 : bx;
          const int lane_ = pg8::lane_id_asm(), gw_ = vbx_ * NWAVES + wave_s;
          LAS unsigned char* vlds = lds + wave_s * 16384;
          for (int rd_ = 0; rd_ < PROBE_DIL; ++rd_) for (int u = vbx_; u < 256; u += G) dil_block((const bf16_t*)(ws + WS_PROJ), (bf16_t*)(ws + WS_ATTA), lds, u, wave_s, lane_);
          for (int rs_ = 0; rs_ < PROBE_SB; ++rs_) for (int u = gw_; u < 4096 / NH; u += ngw) sb_unit((const bf16_t*)(ws + WS_PROJ), (bf16_t*)(ws + WS_ATTB), vlds, u, lane_);
        }
        GRID_BAR();
        { size_t z_ = 0; asm volatile("" : "+s"(z_)); unsigned char* ws = a.ws + z_; float* outp = a.out + z_; const float* xin = a.x + z_;     unsigned char* set = ws + WS_W + (size_t)(l & 1) * W_SET;
          pg8::Gemm g{(const bf16_t*)(ws + WS_ATTA), (const bf16_t*)(set + W_PA), M, D, 256}; pg8::StaticOrder S; S.init(M, D, G, bx);
          pg8::EpiGate<0> E{(bf16_t*)(ws + WS_MIX), (const bf16_t*)(ws + WS_PROJ)};
          pg8::gemm_phase<pg8::EpiGate<0>, pg8::StaticOrder, true, true>(lds, g, S, E, wave_s); }
        { size_t z_ = 0; asm volatile("" : "+s"(z_)); unsigned char* ws = a.ws + z_; float* outp = a.out + z_; const float* xin = a.x + z_;     unsigned char* set = ws + WS_W + (size_t)(l & 1) * W_SET;
          pg8::Gemm g{(const bf16_t*)(ws + WS_ATTB), (const bf16_t*)(set + W_PB), M, D, 256}; pg8::StaticOrder S; S.init(M, D, G, bx);
          pg8::EpiGate<1> E{(bf16_t*)(ws + WS_MIX), (const bf16_t*)(ws + WS_PROJ)};
          pg8::gemm_phase<pg8::EpiGate<1>, pg8::StaticOrder, true, true>(lds, g, S, E, wave_s); }
        GRID_BAR();
        { size_t z_ = 0; asm volatile("" : "+s"(z_)); unsigned char* ws = a.ws + z_; float* outp = a.out + z_; const float* xin = a.x + z_;     unsigned char* set = ws + WS_W + (size_t)(l & 1) * W_SET;
          pg8::Gemm g{(const bf16_t*)(ws + WS_MIX), (const bf16_t*)(set + W_OUT), M, D, D}; pg8::StaticOrder S; S.init(M, D, G, bx);
          pg8::EpiResid E{l == 0 ? xin : outp, outp, (bf16_t*)(ws + WS_XB), (float*)(ws + WS_SS) + (size_t)(2 * l + 1) * M * 16};
          pg8::gemm_phase<pg8::EpiResid, pg8::StaticOrder, true, true>(lds, g, S, E, wave_s); }
        GRID_BAR();
        for (int rp_ = 0; rp_ < PROBE_G4; ++rp_) { size_t z_ = 0; asm volatile("" : "+s"(z_)); unsigned char* ws = a.ws + z_; unsigned char* set = ws + WS_W + (size_t)(l & 1) * W_SET;
          const float* cw_ = a.conv_w + (size_t)l * 3 * DFF + z_; const float* cb_ = a.conv_b + (size_t)l * DFF + z_;
          pg8::Gemm g{(const bf16_t*)(ws + WS_XB), (const bf16_t*)(set + W_UP), M, NUP, D}; pg8::StaticOrder S; S.init(M, NUP, G, bx);
          pg8::EpiUpConv E{(bf16_t*)(ws + WS_G), (bf16_t*)(ws + WS_EXA), (bf16_t*)(ws + WS_EXB), (const float*)(ws + WS_SS) + (size_t)(2 * l + 1) * M * 16, cw_, cb_, (LAS float*)(lds + 131072 + 1024) + wave_s * 128, -1};
          pg8::gemm_phase<pg8::EpiUpConv, pg8::StaticOrder, true, true>(lds, g, S, E, wave_s);
          if (l + 1 < DEPTH) {
              const int nun = (M / 256) * (NUP / 256), rem = nun % G, lane_ = pg8::lane_id_asm();
              for (int rc_ = 0; rc_ < PROBE_CONV; ++rc_) {
                  if (rem == 0) convert_layer(a, l + 1, lds, bx * NWAVES + wave_s, ngw, wave_s, lane_);
                  else if (bx >= rem) convert_layer(a, l + 1, lds, (bx - rem) * NWAVES + wave_s, (G - rem) * NWAVES, wave_s, lane_);
              } } }
        GRID_BAR();
        { size_t z_ = 0; asm volatile("" : "+s"(z_)); unsigned char* ws = a.ws + z_; float* outp = a.out + z_; const float* xin = a.x + z_;     unsigned char* set = ws + WS_W + (size_t)(l & 1) * W_SET;
          pg8::Gemm g{(const bf16_t*)(ws + WS_G), (const bf16_t*)(set + W_DN), M, D, DFF}; pg8::StaticOrder S; S.init(M, D, G, bx);
          { const float* cw_ = a.conv_w + (size_t)l * 3 * DFF + z_; const float* cb_ = a.conv_b + (size_t)l * DFF + z_;
            const int tid_ = wave_s * 64 + pg8::lane_id_asm(); pg8::Unit fu;
            for (int i = 0; S.next(i, fu); ++i) fixup_panel((bf16_t*)(ws + WS_G), (const bf16_t*)(ws + WS_EXA), (const bf16_t*)(ws + WS_EXB), cw_, cb_, fu.pm, tid_);
            asm volatile("s_waitcnt vmcnt(0)" ::: "memory"); __syncthreads(); }
          pg8::EpiResid E{outp, outp, (bf16_t*)(ws + WS_XB), (float*)(ws + WS_SS) + (size_t)(2 * l + 2) * M * 16};
          pg8::gemm_phase<pg8::EpiResid, pg8::StaticOrder, true, true>(lds, g, S, E, wave_s); }
        GRID_BAR();
    }
    { const int lanef = pg8::lane_id_asm(), gwf = bx * NWAVES + wave_s;
      const float* SS8 = (const float*)(a.ws + WS_SS) + (size_t)8 * M * 16;
      for (int row = gwf; row < M; row += ngw) {
        float ssv = SS8[(size_t)row * 16 + (lanef & 15)]; ssv += __shfl_xor(ssv, 1); ssv += __shfl_xor(ssv, 2); ssv += __shfl_xor(ssv, 4); ssv += __shfl_xor(ssv, 8);
        const float rs = rsqrtf(ssv * (1.0f / 1024.0f) + 1e-5f);
        f32x4* xr = (f32x4*)(a.out + (size_t)row * D) + lanef; const f32x4* gr = (const f32x4*)a.norm_final + lanef;
#pragma unroll
        for (int j = 0; j < 4; ++j) { const f32x4 v = xr[64 * j], gg = gr[64 * j]; xr[64 * j] = v * rs * gg; }
      } }
}

extern "C" void kernel_launch(void* const* d_in, const int* in_sizes, int n_in, void* d_out, int out_size, void* d_ws, size_t ws_size, hipStream_t stream) {
    static int grid = 0;
    if (grid == 0) {
        if (n_in != 14 || in_sizes[0] != M * D || out_size != M * D || ws_size < WS_END) { fprintf(stderr, "kernel_launch: unexpected shapes (n_in %d, in0 %d, out %d, ws %zu)\n", n_in, n_in > 0 ? in_sizes[0] : -1, out_size, ws_size); grid = -1; return; }
        int dev = 0, cus = 0, per_cu = 0;
        (void)hipGetDevice(&dev); (void)hipDeviceGetAttribute(&cus, hipDeviceAttributeMultiprocessorCount, dev);
        if (hipFuncSetAttribute((const void*)mk_fwd, hipFuncAttributeMaxDynamicSharedMemorySize, LDS_BYTES) != hipSuccess) { fprintf(stderr, "kernel_launch: hipFuncSetAttribute failed\n"); grid = -1; return; }
        if (hipOccupancyMaxActiveBlocksPerMultiprocessor(&per_cu, (const void*)mk_fwd, NWAVES * 64, LDS_BYTES) != hipSuccess || per_cu < 1) { fprintf(stderr, "kernel_launch: occupancy query says %d\n", per_cu); per_cu = 1; }
        (void)hipGetLastError();
        grid = cus * per_cu;
    }
    if (grid < 0) return;
    Args a{};
    a.x = (const float*)d_in[0]; a.pos = (const int*)d_in[1]; a.norm_mix = (const float*)d_in[2]; a.w_in = (const float*)d_in[3]; a.b_gate = (const float*)d_in[4];
    a.w_proj_a = (const float*)d_in[5]; a.w_proj_b = (const float*)d_in[6]; a.w_out = (const float*)d_in[7]; a.norm_ffn = (const float*)d_in[8]; a.w_up = (const float*)d_in[9];
    a.conv_w = (const float*)d_in[10]; a.conv_b = (const float*)d_in[11]; a.w_down = (const float*)d_in[12]; a.norm_final = (const float*)d_in[13];
    a.out = (float*)d_out; a.ws = (unsigned char*)d_ws;
    for (int i = 0; i < 8; ++i) a.inv_freq[i] = (float)pow(500000.0, -(double)i / 8.0);
    if (hipMemsetAsync((unsigned char*)d_ws + WS_BAR, 0, 16384, stream) != hipSuccess) { fprintf(stderr, "kernel_launch: memset failed\n"); return; }
    void* args[] = {&a};
    const hipError_t e = hipLaunchCooperativeKernel((const void*)mk_fwd, dim3(grid), dim3(NWAVES * 64), args, LDS_BYTES, stream);
    if (e != hipSuccess) fprintf(stderr, "kernel_launch: cooperative launch failed: %s (grid %d)\n", hipGetErrorString(e), grid);
}
```
